# Optimizing an MI355X kernel written in HIP

```python
import math
import jax, jax.numpy as jnp
from jax import lax
import numpy as np


D_MODEL = 1024
BATCH = 8
SEQ = 8192
DEPTH = 1

MIX_WIDTH = D_MODEL
DIFF_WIDTH = MIX_WIDTH // 2
DIFF_QK_DIM = 64
DIFF_V_DIM = 2 * DIFF_QK_DIM
DIFF_HEADS = DIFF_WIDTH // DIFF_V_DIM
RWKV_WIDTH = MIX_WIDTH - DIFF_WIDTH
RWKV_HEAD_DIM = 64
RWKV_HEADS = RWKV_WIDTH // RWKV_HEAD_DIM
DECAY_LORA = 64
ICLR_LORA = 64
GATE_LORA = 128
N_DIR = 2
DIFF_COLS = 3 * DIFF_WIDTH
RWKV_COLS = 3 * RWKV_WIDTH + N_DIR * DECAY_LORA + N_DIR * ICLR_LORA + GATE_LORA
IN_COLS = DIFF_COLS + RWKV_COLS
D_FF = 2816
CONV_WIDTH = 3
ROPE_THETA = 10000.0
Q_BLOCK = 128
NORM_EPS = 1e-6
GN_EPS = 64e-5

kernel_name = "hybrid_diffattn_rwkv7_encoder"


def rms_norm(x, g):
    xf = x.astype(jnp.float32)
    y = xf * lax.rsqrt(jnp.mean(xf * xf, axis=-1, keepdims=True) + NORM_EPS)
    return (y * g.astype(jnp.float32)).astype(x.dtype)


def shift_prev(z):
    return jnp.pad(z[:, :-1], ((0, 0), (1, 0), (0, 0)))


def shift_next(z):
    return jnp.pad(z[:, 1:], ((0, 0), (0, 1), (0, 0)))


def rope(t, pos):
    half = t.shape[-1] // 2
    inv = ROPE_THETA ** (-jnp.arange(half, dtype=jnp.float32) / half)
    ang = pos[:, None] * inv[None, :]
    cos = jnp.cos(ang)[None, :, None, None, :]
    sin = jnp.sin(ang)[None, :, None, None, :]
    t1 = t[..., :half].astype(jnp.float32)
    t2 = t[..., half:].astype(jnp.float32)
    return jnp.concatenate([t1 * cos - t2 * sin, t2 * cos + t1 * sin], axis=-1).astype(t.dtype)


def diff_attention(q, k, v, lam_q1, lam_k1, lam_q2, lam_k2, subln_g, lambda_init):
    B, S = q.shape[0], q.shape[1]
    pos = jnp.arange(S, dtype=jnp.float32)
    q = rope(q.reshape(B, S, DIFF_HEADS, 2, DIFF_QK_DIM), pos)
    k = rope(k.reshape(B, S, DIFF_HEADS, 2, DIFF_QK_DIM), pos)
    v = v.reshape(B, S, DIFF_HEADS, DIFF_V_DIM)
    lam = (jnp.exp(jnp.sum(lam_q1.astype(jnp.float32) * lam_k1.astype(jnp.float32)))
           - jnp.exp(jnp.sum(lam_q2.astype(jnp.float32) * lam_k2.astype(jnp.float32)))
           + lambda_init)
    scale = DIFF_QK_DIM ** -0.5
    n_blk = S // Q_BLOCK
    qb = q.reshape(B, n_blk, Q_BLOCK, DIFF_HEADS, 2, DIFF_QK_DIM).transpose(1, 0, 2, 3, 4, 5)

    def block(q_blk):
        s = jnp.einsum('bqhcd,bkhcd->bhcqk', q_blk, k).astype(jnp.float32) * scale
        p = jax.nn.softmax(s, axis=-1)
        attn = p[:, :, 0] - lam * p[:, :, 1]
        return jnp.einsum('bhqk,bkhv->bqhv', attn.astype(v.dtype), v)

    o = lax.map(block, qb)
    o = o.transpose(1, 0, 2, 3, 4).reshape(B, S, DIFF_HEADS, DIFF_V_DIM)
    o = rms_norm(o, subln_g) * (1.0 - lambda_init)
    return o.reshape(B, S, DIFF_WIDTH)


def wkv_scan(r, w, k, v, kk, a):
    xs = tuple(jnp.swapaxes(t, 0, 1) for t in (r, w, k, v, kk, a))
    B, _, H, N = r.shape
    s0 = jnp.zeros((B, H, N, N), r.dtype)

    def step(state, inp):
        r_t, w_t, k_t, v_t, kk_t, a_t = inp
        sa = jnp.einsum('bhij,bhj->bhi', state, -kk_t)
        state = (state * w_t[:, :, None, :]
                 + sa[:, :, :, None] * (kk_t * a_t)[:, :, None, :]
                 + v_t[:, :, :, None] * k_t[:, :, None, :])
        return state, jnp.einsum('bhij,bhj->bhi', state, r_t)

    _, y = lax.scan(step, s0, xs)
    return jnp.swapaxes(y, 0, 1)


def rwkv_time_mix(z, mu, w0, w2, a0, a2, g2, k_k, k_a, r_k, gn_w, gn_b):
    B, S = z.shape[0], z.shape[1]
    z = z + (0.5 * (shift_prev(z) + shift_next(z)) - z) * mu
    o1 = RWKV_WIDTH
    o2 = 2 * RWKV_WIDTH
    o3 = 3 * RWKV_WIDTH
    o4 = o3 + N_DIR * DECAY_LORA
    o5 = o4 + N_DIR * ICLR_LORA
    r, k, v = z[..., :o1], z[..., o1:o2], z[..., o2:o3]
    wd = z[..., o3:o4].reshape(B, S, N_DIR, DECAY_LORA)
    ad = z[..., o4:o5].reshape(B, S, N_DIR, ICLR_LORA)
    gd = z[..., o5:]

    def hs(t):
        return t.reshape(B, S, RWKV_HEADS, RWKV_HEAD_DIM)

    g = jax.nn.sigmoid(gd) @ g2
    kkf = hs(k * k_k).astype(jnp.float32)
    kk = (kkf * lax.rsqrt(jnp.maximum(jnp.sum(kkf * kkf, axis=-1, keepdims=True), 1e-12))).astype(k.dtype)
    rh, vh = hs(r), hs(v)
    y_sum = jnp.zeros_like(rh)
    bonus = jnp.zeros_like(rh)
    for d in range(N_DIR):
        w_log = -jax.nn.softplus(-(w0[d] + jnp.tanh(wd[:, :, d]) @ w2[d])) - 0.5
        decay = jnp.exp(-jnp.exp(w_log))
        a = jax.nn.sigmoid(a0[d] + ad[:, :, d] @ a2[d])
        kd = k * (1.0 + (a - 1.0) * k_a)
        args = (rh, hs(decay), hs(kd), vh, kk, hs(a))
        if d == 0:
            y = wkv_scan(*args)
        else:
            y = jnp.flip(wkv_scan(*[jnp.flip(t, axis=1) for t in args]), axis=1)
        y_sum = y_sum + y
        bonus = bonus + jnp.sum(rh * hs(kd) * r_k, axis=-1, keepdims=True) * vh
    yf = y_sum.astype(jnp.float32)
    mean = jnp.mean(yf, axis=-1, keepdims=True)
    var = jnp.mean(jnp.square(yf - mean), axis=-1, keepdims=True)
    yn = ((yf - mean) * lax.rsqrt(var + GN_EPS)).reshape(B, S, RWKV_WIDTH)
    yn = (yn * gn_w.astype(jnp.float32) + gn_b.astype(jnp.float32)).astype(z.dtype)
    return (yn + bonus.reshape(B, S, RWKV_WIDTH)) * g


def conv_ffn(z, w_up, conv_w, conv_b, w_down):
    gate, up = jnp.split(z @ w_up, 2, axis=-1)
    gate = conv_w[0] * shift_prev(gate) + conv_w[1] * gate + conv_w[2] * shift_next(gate) + conv_b
    return (jax.nn.gelu(gate, approximate=True) * up) @ w_down


def setup_inputs(seed: int = 0) -> dict:
    key = jax.random.key(seed)
    ks = jax.random.split(key, 32)
    L = DEPTH
    f32 = jnp.float32

    def nrm(k, shape, s):
        return jax.random.normal(k, shape, f32) * s

    return {
        "x": nrm(ks[0], (BATCH, SEQ, D_MODEL), 1.0),
        "pre_mix_norm": 1.0 + nrm(ks[1], (L, D_MODEL), 0.02),
        "post_mix_norm": 1.0 + nrm(ks[2], (L, D_MODEL), 0.02),
        "pre_ffn_norm": 1.0 + nrm(ks[3], (L, D_MODEL), 0.02),
        "post_ffn_norm": 1.0 + nrm(ks[4], (L, D_MODEL), 0.02),
        "w_in": nrm(ks[5], (L, D_MODEL, IN_COLS), D_MODEL ** -0.5),
        "diff_lambda_q1": nrm(ks[6], (L, DIFF_QK_DIM), 0.1),
        "diff_lambda_k1": nrm(ks[7], (L, DIFF_QK_DIM), 0.1),
        "diff_lambda_q2": nrm(ks[8], (L, DIFF_QK_DIM), 0.1),
        "diff_lambda_k2": nrm(ks[9], (L, DIFF_QK_DIM), 0.1),
        "diff_subln": 1.0 + nrm(ks[10], (L, DIFF_V_DIM), 0.02),
        "rwkv_mu": jax.random.uniform(ks[11], (L, RWKV_COLS), f32, 0.0, 1.0),
        "rwkv_w0": jax.random.uniform(ks[12], (L, N_DIR, RWKV_WIDTH), f32, -6.0, 1.0),
        "rwkv_w2": nrm(ks[13], (L, N_DIR, DECAY_LORA, RWKV_WIDTH), 0.5 * DECAY_LORA ** -0.5),
        "rwkv_a0": nrm(ks[14], (L, N_DIR, RWKV_WIDTH), 0.5),
        "rwkv_a2": nrm(ks[15], (L, N_DIR, ICLR_LORA, RWKV_WIDTH), 0.5 * ICLR_LORA ** -0.5),
        "rwkv_g2": nrm(ks[16], (L, GATE_LORA, RWKV_WIDTH), GATE_LORA ** -0.5),
        "rwkv_k_k": 0.85 + nrm(ks[17], (L, RWKV_WIDTH), 0.05),
        "rwkv_k_a": 1.0 + nrm(ks[18], (L, RWKV_WIDTH), 0.05),
        "rwkv_r_k": nrm(ks[19], (L, RWKV_HEADS, RWKV_HEAD_DIM), 0.1),
        "rwkv_gn_w": 1.0 + nrm(ks[20], (L, RWKV_WIDTH), 0.02),
        "rwkv_gn_b": nrm(ks[21], (L, RWKV_WIDTH), 0.02),
        "w_out": nrm(ks[22], (L, MIX_WIDTH, D_MODEL), MIX_WIDTH ** -0.5),
        "w_up": nrm(ks[23], (L, D_MODEL, 2 * D_FF), D_MODEL ** -0.5),
        "ffn_conv_w": nrm(ks[24], (L, CONV_WIDTH, D_FF), CONV_WIDTH ** -0.5),
        "ffn_conv_b": nrm(ks[25], (L, D_FF), 0.02),
        "w_down": nrm(ks[26], (L, D_FF, D_MODEL), D_FF ** -0.5),
    }


def reference(x, pre_mix_norm, post_mix_norm, pre_ffn_norm, post_ffn_norm, w_in,
              diff_lambda_q1, diff_lambda_k1, diff_lambda_q2, diff_lambda_k2, diff_subln,
              rwkv_mu, rwkv_w0, rwkv_w2, rwkv_a0, rwkv_a2, rwkv_g2, rwkv_k_k, rwkv_k_a,
              rwkv_r_k, rwkv_gn_w, rwkv_gn_b, w_out, w_up, ffn_conv_w, ffn_conv_b, w_down):
    for l in range(DEPTH):
        lambda_init = 0.8 - 0.6 * math.exp(-0.3 * l)
        h = rms_norm(x, pre_mix_norm[l])
        proj = h @ w_in[l]
        dq = proj[..., :DIFF_WIDTH]
        dk = proj[..., DIFF_WIDTH:2 * DIFF_WIDTH]
        dv = proj[..., 2 * DIFF_WIDTH:DIFF_COLS]
        rw = proj[..., DIFF_COLS:]
        ya = diff_attention(dq, dk, dv, diff_lambda_q1[l], diff_lambda_k1[l],
                            diff_lambda_q2[l], diff_lambda_k2[l], diff_subln[l], lambda_init)
        yb = rwkv_time_mix(rw, rwkv_mu[l], rwkv_w0[l], rwkv_w2[l], rwkv_a0[l], rwkv_a2[l],
                           rwkv_g2[l], rwkv_k_k[l], rwkv_k_a[l], rwkv_r_k[l],
                           rwkv_gn_w[l], rwkv_gn_b[l])
        mix = jnp.concatenate([ya, yb], axis=-1) @ w_out[l]
        x = x + rms_norm(mix, post_mix_norm[l])
        h = rms_norm(x, pre_ffn_norm[l])
        f = conv_ffn(h, w_up[l], ffn_conv_w[l], ffn_conv_b[l], w_down[l])
        x = x + rms_norm(f, post_ffn_norm[l])
    return x
```

```cpp
#include <hip/hip_runtime.h>
#include <hip/hip_cooperative_groups.h>
#include <cstdio>
namespace cg = cooperative_groups;

typedef unsigned short bf16_t;
typedef short bf16x8 __attribute__((ext_vector_type(8)));
typedef float f32x4 __attribute__((ext_vector_type(4)));
typedef float f32x2 __attribute__((ext_vector_type(2)));
typedef unsigned int u32;
typedef u32 u32x4 __attribute__((ext_vector_type(4)));
typedef u32 u32x2 __attribute__((ext_vector_type(2)));

#define DI __device__ __forceinline__

constexpr int T = 65536, S = 8192, D = 1024, NIN = 3456, NRW = 1920, DFF = 2816;
constexpr size_t MiB = 1ull << 20;
constexpr size_t O_WINT = 0, O_WOUTT = 7 * MiB, O_WUPT = 9 * MiB, O_WDOWNT = 20 * MiB;
constexpr size_t O_W2T = 26 * MiB, O_A2T = O_W2T + 131072, O_G2T = O_W2T + 262144;
constexpr size_t O_ROPE = 27 * MiB, O_RSTD1 = 29 * MiB, O_RSTD2 = O_RSTD1 + 262144, O_MISC = 30 * MiB;
constexpr size_t O_XB = 32 * MiB, O_LIN = 32 * MiB, O_YCAT = 32 * MiB, O_ACT = 32 * MiB;
constexpr size_t O_QK = 160 * MiB, O_VT = 288 * MiB, O_MIX = 160 * MiB;
constexpr size_t O_Z = 352 * MiB, O_E0 = 352 * MiB, O_E1 = 416 * MiB, O_A0 = 480 * MiB, O_A1 = 544 * MiB, O_GG = 608 * MiB;
constexpr size_t O_RS = 672 * MiB, O_KS = 736 * MiB, O_VS = 800 * MiB, O_KK = 864 * MiB;
constexpr size_t O_X1B = 416 * MiB, O_G = 544 * MiB, O_F = 544 * MiB;
constexpr size_t WS_END = 928 * MiB;

constexpr int LDS_BYTES = 114688;
constexpr float QSCALE = 0.125f * 1.4426950408889634f;

struct Params {
  const float *x, *pre_mix, *post_mix, *pre_ffn, *post_ffn, *w_in, *lq1, *lk1, *lq2, *lk2, *subln, *mu, *w0, *w2, *a0, *a2, *g2,
      *k_k, *k_a, *r_k, *gn_w, *gn_b, *w_out, *w_up, *conv_w, *conv_b, *w_down;
  float* out;
  unsigned char* ws;
};

typedef __bf16 bf16x2_t __attribute__((ext_vector_type(2)));
DI u32 pk2(float lo, float hi) {
  f32x2 f = {lo, hi};
  bf16x2_t b = __builtin_convertvector(f, bf16x2_t);
  return __builtin_bit_cast(u32, b);
}
DI bf16_t f2bf(float f) { return (bf16_t)(pk2(f, 0.f) & 0xffffu); }
DI float bf2f(u32 h) { return __uint_as_float(h << 16); }
DI float bflo(u32 w) { return __uint_as_float(w << 16); }
DI float bfhi(u32 w) { return __uint_as_float(w & 0xffff0000u); }
DI void st_bf4(bf16_t* p, f32x4 v) {
  u32x2 o;
  o.x = pk2(v[0], v[1]);
  o.y = pk2(v[2], v[3]);
  *(u32x2*)p = o;
}
DI float wave_sum(float v) {
#pragma unroll
  for (int o = 1; o < 64; o <<= 1) v += __shfl_xor(v, o);
  return v;
}
DI float sigmoidf_(float u) { return 1.f / (1.f + __expf(-u)); }
template <int CTRL>
DI float dppf(float v) {
  return __builtin_bit_cast(float, __builtin_amdgcn_update_dpp(0, __builtin_bit_cast(int, v), CTRL, 0xF, 0xF, true));
}
DI float row_sum16(float v) {
  v += dppf<0x128>(v);
  v += dppf<0x124>(v);
  v += dppf<0x122>(v);
  v += dppf<0x121>(v);
  return v;
}


DI void gsync(unsigned* bar, unsigned target) {
  __threadfence();
  __syncthreads();
  if (threadIdx.x == 0) {
    __hip_atomic_fetch_add(bar, 1u, __ATOMIC_RELEASE, __HIP_MEMORY_SCOPE_AGENT);
    while (__hip_atomic_load(bar, __ATOMIC_RELAXED, __HIP_MEMORY_SCOPE_AGENT) < target) __builtin_amdgcn_s_sleep(2);
  }
  __syncthreads();
  __builtin_amdgcn_fence(__ATOMIC_ACQUIRE, "agent");
}

DI void transpose_job(const float* src, int K, int N, bf16_t* dst, const float* g, bool perm, float* tile, int bid, int nb, int tid) {
  const int nnt = N / 64, nit = (K / 64) * nnt;
  for (int it = bid; it < nit; it += nb) {
    const int kt = it / nnt, nt = it % nnt, k0 = kt * 64, n0 = nt * 64;
#pragma unroll
    for (int i = 0; i < 8; ++i) {
      const int kk = (tid >> 6) + 8 * i, nn = tid & 63;
      float v = src[(size_t)(k0 + kk) * N + n0 + nn];
      if (g) v *= g[k0 + kk];
      tile[kk * 65 + nn] = v;
    }
    __syncthreads();
#pragma unroll
    for (int i = 0; i < 8; ++i) {
      const int nn = (tid >> 6) + 8 * i, kk = tid & 63;
      const int n = n0 + nn;
      int nd = n;
      if (perm && n < 1024) {
        const int d = n & 63;
        nd = (n & ~63) | (2 * (d & 31) + (d >> 5));
      }
      dst[(size_t)nd * K + k0 + kk] = f2bf(tile[kk * 65 + nn]);
    }
    __syncthreads();
  }
}

constexpr int G_ASTAGE = 256 * 144, G_BSTAGE = 128 * 144, G_STAGE = G_ASTAGE + G_BSTAGE;

template <bool SWAP, class Epi>
DI void gemm_tile(const bf16_t* __restrict__ A, int lda, const bf16_t* __restrict__ Bt, int ldb, int K, int m0, int n0,
                  unsigned char* lds, const Epi& epi, int tid) {
  const int lane = tid & 63, wave = tid >> 6, wm = wave >> 1, wn = wave & 1, fr = lane & 15, fg = lane >> 4;
  f32x4 acc[4][4];
#pragma unroll
  for (int i = 0; i < 4; ++i)
#pragma unroll
    for (int j = 0; j < 4; ++j) acc[i][j] = (f32x4){0.f, 0.f, 0.f, 0.f};
  const int nk = K / 64;
  const int srow = tid >> 3, skc = tid & 7;
  const bf16_t* ga = A + (size_t)(m0 + srow) * lda + skc * 8;
  const bf16_t* gb = Bt + (size_t)(n0 + srow) * ldb + skc * 8;
  u32x4 ra[4], rb[2];
#pragma unroll
  for (int i = 0; i < 4; ++i) ra[i] = *(const u32x4*)(ga + (size_t)(64 * i) * lda);
#pragma unroll
  for (int i = 0; i < 2; ++i) rb[i] = *(const u32x4*)(gb + (size_t)(64 * i) * ldb);
  {
    unsigned char* as = lds;
    unsigned char* bs = lds + G_ASTAGE;
#pragma unroll
    for (int i = 0; i < 4; ++i) *(u32x4*)(as + (srow + 64 * i) * 144 + skc * 16) = ra[i];
#pragma unroll
    for (int i = 0; i < 2; ++i) *(u32x4*)(bs + (srow + 64 * i) * 144 + skc * 16) = rb[i];
  }
  __syncthreads();
  for (int kt = 0; kt < nk; ++kt) {
    const bool more = (kt + 1 < nk);
    if (more) {
#pragma unroll
      for (int i = 0; i < 4; ++i) ra[i] = *(const u32x4*)(ga + (size_t)(64 * i) * lda + (kt + 1) * 64);
#pragma unroll
      for (int i = 0; i < 2; ++i) rb[i] = *(const u32x4*)(gb + (size_t)(64 * i) * ldb + (kt + 1) * 64);
    }
    const unsigned char* as = lds + (kt & 1) * G_STAGE;
    const unsigned char* bs = as + G_ASTAGE;
#pragma unroll
    for (int ks = 0; ks < 2; ++ks) {
      bf16x8 af[4], bfr[4];
#pragma unroll
      for (int i = 0; i < 4; ++i) af[i] = *(const bf16x8*)(as + (wm * 64 + i * 16 + fr) * 144 + ks * 64 + fg * 16);
#pragma unroll
      for (int i = 0; i < 4; ++i) bfr[i] = *(const bf16x8*)(bs + (wn * 64 + i * 16 + fr) * 144 + ks * 64 + fg * 16);
#pragma unroll
      for (int mi = 0; mi < 4; ++mi)
#pragma unroll
        for (int ni = 0; ni < 4; ++ni) {
          if (SWAP) acc[mi][ni] = __builtin_amdgcn_mfma_f32_16x16x32_bf16(af[mi], bfr[ni], acc[mi][ni], 0, 0, 0);
          else acc[mi][ni] = __builtin_amdgcn_mfma_f32_16x16x32_bf16(bfr[ni], af[mi], acc[mi][ni], 0, 0, 0);
        }
    }
    if (more) {
      unsigned char* as2 = lds + ((kt + 1) & 1) * G_STAGE;
      unsigned char* bs2 = as2 + G_ASTAGE;
#pragma unroll
      for (int i = 0; i < 4; ++i) *(u32x4*)(as2 + (srow + 64 * i) * 144 + skc * 16) = ra[i];
#pragma unroll
      for (int i = 0; i < 2; ++i) *(u32x4*)(bs2 + (srow + 64 * i) * 144 + skc * 16) = rb[i];
    }
    __syncthreads();
  }
#pragma unroll
  for (int mi = 0; mi < 4; ++mi)
#pragma unroll
    for (int ni = 0; ni < 4; ++ni) {
      if (SWAP) epi(m0 + wm * 64 + mi * 16 + fg * 4, n0 + wn * 64 + ni * 16 + fr, acc[mi][ni]);
      else epi(m0 + wm * 64 + mi * 16 + fr, n0 + wn * 64 + ni * 16 + fg * 4, acc[mi][ni]);
    }
}

struct EpiInProj {
  const float* rstd; const f32x2* rope; bf16_t* qk; bf16_t* z;
  DI void operator()(int m, int n, f32x4 v) const {
    const float rs = rstd[m];
    v = v * rs;
    if (n < 1024) {
      const int s = m & (S - 1), i = (n & 63) >> 1;
      const f32x2 c0 = rope[s * 32 + i], c1 = rope[s * 32 + i + 1];
      float a = v[0], b = v[1];
      v[0] = a * c0.x - b * c0.y; v[1] = b * c0.x + a * c0.y;
      a = v[2]; b = v[3];
      v[2] = a * c1.x - b * c1.y; v[3] = b * c1.x + a * c1.y;
      if (n < 512) v = v * QSCALE;
      st_bf4(qk + (size_t)m * 1024 + n, v);
    } else {
      st_bf4(z + (size_t)m * NRW + (n - 1536), v);
    }
  }
};
struct EpiV {
  const float* rstd; bf16_t* vt;
  DI void operator()(int m, int n, f32x4 v) const {
    const f32x4 rs = *(const f32x4*)(rstd + m);
    v = v * rs;
    const int nn = n - 1024, h = nn >> 7, vd = nn & 127, b = m >> 13, s = m & (S - 1);
    st_bf4(vt + ((size_t)((b * 4 + h) * 128 + vd)) * S + s, v);
  }
};
struct EpiLora {
  int mode; const float* bias; bf16_t* out;
  DI void operator()(int m, int n, f32x4 v) const {
    if (mode < 2) {
      const f32x4 bv = *(const f32x4*)(bias + n);
      const float sc = mode == 0 ? 0.60653065971f : 1.f;
#pragma unroll
      for (int j = 0; j < 4; ++j) v[j] = sc * sigmoidf_(v[j] + bv[j]);
    }
    st_bf4(out + (size_t)m * 512 + n, v);
  }
};
struct EpiF32 {
  float* out; int ld;
  DI void operator()(int m, int n, f32x4 v) const { *(f32x4*)(out + (size_t)m * ld + n) = v; }
};
struct EpiGate {
  const float* rstd; bf16_t* g;
  DI void operator()(int m, int n, f32x4 v) const { st_bf4(g + (size_t)m * DFF + n, v * rstd[m]); }
};
struct EpiUp {
  const float* rstd; const bf16_t* g; const float* cw; const float* cb; bf16_t* act;
  DI void operator()(int m, int n, f32x4 v) const {
    v = v * rstd[m];
    const int s = m & (S - 1);
    const bf16_t* gp = g + (size_t)m * DFF + n;
    const u32x2 g0 = *(const u32x2*)gp;
    u32x2 gm = (u32x2){0u, 0u}, gn = (u32x2){0u, 0u};
    if (s > 0) gm = *(const u32x2*)(gp - DFF);
    if (s < S - 1) gn = *(const u32x2*)(gp + DFF);
    const f32x4 w0 = *(const f32x4*)(cw + n), w1 = *(const f32x4*)(cw + DFF + n), w2 = *(const f32x4*)(cw + 2 * DFF + n), bb = *(const f32x4*)(cb + n);
    f32x4 c, p, q;
    c[0] = bflo(g0.x); c[1] = bfhi(g0.x); c[2] = bflo(g0.y); c[3] = bfhi(g0.y);
    p[0] = bflo(gm.x); p[1] = bfhi(gm.x); p[2] = bflo(gm.y); p[3] = bfhi(gm.y);
    q[0] = bflo(gn.x); q[1] = bfhi(gn.x); q[2] = bflo(gn.y); q[3] = bfhi(gn.y);
    f32x4 o;
#pragma unroll
    for (int j = 0; j < 4; ++j) {
      const float xg = w0[j] * p[j] + w1[j] * c[j] + w2[j] * q[j] + bb[j];
      const float y = 0.7978845608028654f * (xg + 0.044715f * xg * xg * xg);
      o[j] = xg / (1.f + __expf(-2.f * y)) * v[j];
    }
    st_bf4(act + (size_t)m * DFF + n, o);
  }
};

template <bool SWAP, class Epi>
DI void gemm_phase(const bf16_t* A, int lda, const bf16_t* Bt, int ldb, int K, int ntn, int nt_lo, int nt_hi, unsigned char* lds, const Epi& epi,
                   int bid, int nb, int tid) {
  const int w = nt_hi - nt_lo, total = 256 * w, per = (total + nb - 1) / nb;
  const int lo = bid * per, hi = min(total, lo + per);
  for (int it = lo; it < hi; ++it) {
    const int mt = it / w, nt = nt_lo + it % w;
    gemm_tile<SWAP>(A, lda, Bt, ldb, K, mt * 256, nt * 128, lds, epi, tid);
  }
}

DI void scan_chain(const Params& p, int chain, unsigned char* lds, int tid) {
  const int d = chain & 1, h = (chain >> 1) & 7, b = chain >> 4;
  float* rec = (float*)lds;
  float* ybuf = (float*)(lds + 98304);
  const bf16_t* RS = (const bf16_t*)(p.ws + O_RS);
  const bf16_t* KS = (const bf16_t*)(p.ws + O_KS);
  const bf16_t* VS = (const bf16_t*)(p.ws + O_VS);
  const bf16_t* KK = (const bf16_t*)(p.ws + O_KK);
  const bf16_t* EE = (const bf16_t*)(p.ws + (d ? O_E1 : O_E0));
  const bf16_t* AA = (const bf16_t*)(p.ws + (d ? O_A1 : O_A0));
  float* Y = p.out + (size_t)d * T * 512;
  const int lane = tid & 63, wave = tid >> 6, cgi = lane & 15, rg = lane >> 4, row0 = wave * 8 + rg * 2;
  const float ka = p.k_a[h * 64 + lane];
  float S0[4] = {0.f, 0.f, 0.f, 0.f}, S1[4] = {0.f, 0.f, 0.f, 0.f};
  bf16_t pr[4][6];
  const int ch = h * 64 + lane;
#define SCAN_TOK(n, k) ((size_t)(b * S + (d ? (S - 1 - ((n) * 32 + (k))) : ((n) * 32 + (k)))))
#define SCAN_LOAD(n)                                                      \
  _Pragma("unroll") for (int i = 0; i < 4; ++i) {                         \
    const size_t o_ = SCAN_TOK(n, wave + 8 * i) * 512 + ch;               \
    pr[i][0] = RS[o_]; pr[i][1] = KS[o_]; pr[i][2] = VS[o_];              \
    pr[i][3] = KK[o_]; pr[i][4] = EE[o_]; pr[i][5] = AA[o_];              \
  }
#define SCAN_XFORM(buf)                                                   \
  _Pragma("unroll") for (int i = 0; i < 4; ++i) {                         \
    float* R_ = rec + (buf) * 12288 + (wave + 8 * i) * 384 + lane;        \
    const float r_ = bf2f(pr[i][0]), k_ = bf2f(pr[i][1]), v_ = bf2f(pr[i][2]), kk_ = bf2f(pr[i][3]), e_ = bf2f(pr[i][4]), a_ = bf2f(pr[i][5]); \
    R_[0] = __expf(-e_); R_[64] = kk_; R_[128] = kk_ * a_; R_[192] = k_ * (1.f + (a_ - 1.f) * ka); R_[256] = r_; R_[320] = v_; \
  }
  SCAN_LOAD(0);
  SCAN_XFORM(0);
  __syncthreads();
  for (int n = 0; n < 256; ++n) {
    if (n + 1 < 256) { SCAN_LOAD(n + 1); }
    const float* RB = rec + (n & 1) * 12288;
    float* YB = ybuf + (n & 1) * 2048;
#pragma unroll 4
    for (int k = 0; k < 32; ++k) {
      const float* R = RB + k * 384;
      const f32x4 w4 = *(const f32x4*)(R + cgi * 4), kk4 = *(const f32x4*)(R + 64 + cgi * 4), b4 = *(const f32x4*)(R + 128 + cgi * 4),
                  kd4 = *(const f32x4*)(R + 192 + cgi * 4), r4 = *(const f32x4*)(R + 256 + cgi * 4);
      const f32x2 v2 = *(const f32x2*)(R + 320 + row0);
      float d0 = S0[0] * kk4[0] + S0[1] * kk4[1] + S0[2] * kk4[2] + S0[3] * kk4[3];
      float d1 = S1[0] * kk4[0] + S1[1] * kk4[1] + S1[2] * kk4[2] + S1[3] * kk4[3];
      d0 = row_sum16(d0);
      d1 = row_sum16(d1);
      float y0 = 0.f, y1 = 0.f;
#pragma unroll
      for (int c = 0; c < 4; ++c) {
        S0[c] = S0[c] * w4[c] + (v2.x * kd4[c] - d0 * b4[c]);
        S1[c] = S1[c] * w4[c] + (v2.y * kd4[c] - d1 * b4[c]);
        y0 += S0[c] * r4[c];
        y1 += S1[c] * r4[c];
      }
      y0 = row_sum16(y0);
      y1 = row_sum16(y1);
      if (cgi == 0) *(f32x2*)(YB + k * 64 + row0) = (f32x2){y0, y1};
    }
    if (n + 1 < 256) { SCAN_XFORM((n + 1) & 1); }
    __syncthreads();
    {
      const int k = tid >> 4, c4 = (tid & 15) * 4;
      *(f32x4*)(Y + SCAN_TOK(n, k) * 512 + h * 64 + c4) = *(const f32x4*)(YB + k * 64 + c4);
    }
  }
  __syncthreads();
#undef SCAN_TOK
#undef SCAN_LOAD
#undef SCAN_XFORM
}

constexpr int AT_K = 64 * 272, AT_V = 128 * 144, AT_STAGE = AT_K + AT_V;

DI void attn_item(const Params& p, int item, float lam, unsigned char* lds, int tid) {
  const int qb = item & 63, bh = item >> 6, h = bh & 3, b = bh >> 2;
  const int lane = tid & 63, wave = tid >> 6, fr = lane & 15, fg = lane >> 4;
  const bf16_t* QK = (const bf16_t*)(p.ws + O_QK);
  const bf16_t* VT = (const bf16_t*)(p.ws + O_VT);
  bf16_t* YC = (bf16_t*)(p.ws + O_YCAT);
  const int q0 = b * S + qb * 128 + wave * 16;
  bf16x8 qf[2][2];
#pragma unroll
  for (int c = 0; c < 2; ++c)
#pragma unroll
    for (int ks = 0; ks < 2; ++ks) qf[c][ks] = *(const bf16x8*)(QK + (size_t)(q0 + fr) * 1024 + h * 128 + c * 64 + ks * 32 + fg * 8);
  f32x4 o[2][8];
#pragma unroll
  for (int c = 0; c < 2; ++c)
#pragma unroll
    for (int i = 0; i < 8; ++i) o[c][i] = (f32x4){0.f, 0.f, 0.f, 0.f};
  float mrun[2] = {-1e30f, -1e30f}, lrun[2] = {0.f, 0.f};
  const int krow = tid >> 4, kkc = tid & 15;
  const int vrow = tid >> 3, vkc = tid & 7;
  const bf16_t* gk = QK + (size_t)(b * S + krow) * 1024 + 512 + h * 128 + kkc * 8;
  const bf16_t* gv = VT + (size_t)((b * 4 + h) * 128 + vrow) * S + vkc * 8;
  u32x4 rk[2], rv[2];
#pragma unroll
  for (int i = 0; i < 2; ++i) {
    rk[i] = *(const u32x4*)(gk + (size_t)(32 * i) * 1024);
    rv[i] = *(const u32x4*)(gv + (size_t)(64 * i) * S);
  }
#pragma unroll
  for (int i = 0; i < 2; ++i) {
    *(u32x4*)(lds + (krow + 32 * i) * 272 + kkc * 16) = rk[i];
    *(u32x4*)(lds + AT_K + (vrow + 64 * i) * 144 + vkc * 16) = rv[i];
  }
  __syncthreads();
  for (int kt = 0; kt < 128; ++kt) {
    const bool more = (kt + 1 < 128);
    if (more) {
#pragma unroll
      for (int i = 0; i < 2; ++i) {
        rk[i] = *(const u32x4*)(gk + (size_t)((kt + 1) * 64 + 32 * i) * 1024);
        rv[i] = *(const u32x4*)(gv + (size_t)(64 * i) * S + (kt + 1) * 64);
      }
    }
    const unsigned char* ksm = lds + (kt & 1) * AT_STAGE;
    const unsigned char* vsm = ksm + AT_K;
    bf16x8 pf[2][2];
#pragma unroll
    for (int c = 0; c < 2; ++c) {
      f32x4 s[4];
#pragma unroll
      for (int t4 = 0; t4 < 4; ++t4) {
        s[t4] = (f32x4){0.f, 0.f, 0.f, 0.f};
#pragma unroll
        for (int ks = 0; ks < 2; ++ks) {
          const bf16x8 kf = *(const bf16x8*)(ksm + (t4 * 16 + fr) * 272 + c * 128 + ks * 64 + fg * 16);
          s[t4] = __builtin_amdgcn_mfma_f32_16x16x32_bf16(kf, qf[c][ks], s[t4], 0, 0, 0);
        }
      }
      float mx = s[0][0];
#pragma unroll
      for (int t4 = 0; t4 < 4; ++t4)
#pragma unroll
        for (int j = 0; j < 4; ++j) mx = fmaxf(mx, s[t4][j]);
      mx = fmaxf(mx, __shfl_xor(mx, 16));
      mx = fmaxf(mx, __shfl_xor(mx, 32));
      const float mn = fmaxf(mrun[c], mx);
      const float alpha = __builtin_amdgcn_exp2f(mrun[c] - mn);
      mrun[c] = mn;
      float ps = 0.f;
#pragma unroll
      for (int t4 = 0; t4 < 4; ++t4)
#pragma unroll
        for (int j = 0; j < 4; ++j) {
          s[t4][j] = __builtin_amdgcn_exp2f(s[t4][j] - mn);
          ps += s[t4][j];
        }
      lrun[c] = lrun[c] * alpha + ps;
#pragma unroll
      for (int i = 0; i < 8; ++i) o[c][i] = o[c][i] * alpha;
#pragma unroll
      for (int ks = 0; ks < 2; ++ks) {
        u32x4 w;
        w.x = pk2(s[2 * ks][0], s[2 * ks][1]);
        w.y = pk2(s[2 * ks][2], s[2 * ks][3]);
        w.z = pk2(s[2 * ks + 1][0], s[2 * ks + 1][1]);
        w.w = pk2(s[2 * ks + 1][2], s[2 * ks + 1][3]);
        pf[c][ks] = __builtin_bit_cast(bf16x8, w);
      }
    }
#pragma unroll
    for (int vt = 0; vt < 8; ++vt)
#pragma unroll
      for (int ks = 0; ks < 2; ++ks) {
        const unsigned char* vp = vsm + (vt * 16 + fr) * 144 + (ks * 32 + fg * 4) * 2;
        const u32x2 lo = *(const u32x2*)vp, hi = *(const u32x2*)(vp + 32);
        const u32x4 w = (u32x4){lo.x, lo.y, hi.x, hi.y};
        const bf16x8 vf = __builtin_bit_cast(bf16x8, w);
        o[0][vt] = __builtin_amdgcn_mfma_f32_16x16x32_bf16(vf, pf[0][ks], o[0][vt], 0, 0, 0);
        o[1][vt] = __builtin_amdgcn_mfma_f32_16x16x32_bf16(vf, pf[1][ks], o[1][vt], 0, 0, 0);
      }
    if (more) {
      unsigned char* k2 = lds + ((kt + 1) & 1) * AT_STAGE;
#pragma unroll
      for (int i = 0; i < 2; ++i) {
        *(u32x4*)(k2 + (krow + 32 * i) * 272 + kkc * 16) = rk[i];
        *(u32x4*)(k2 + AT_K + (vrow + 64 * i) * 144 + vkc * 16) = rv[i];
      }
    }
    __syncthreads();
  }
  float l0 = lrun[0], l1 = lrun[1];
  l0 += __shfl_xor(l0, 16); l0 += __shfl_xor(l0, 32);
  l1 += __shfl_xor(l1, 16); l1 += __shfl_xor(l1, 32);
  const float i0 = 1.f / l0, i1 = lam / l1;
  float ss = 0.f;
#pragma unroll
  for (int vt = 0; vt < 8; ++vt) {
    o[0][vt] = o[0][vt] * i0 - o[1][vt] * i1;
#pragma unroll
    for (int j = 0; j < 4; ++j) ss += o[0][vt][j] * o[0][vt][j];
  }
  ss += __shfl_xor(ss, 16);
  ss += __shfl_xor(ss, 32);
  const float rs = rsqrtf(ss * (1.f / 128.f) + 1e-6f) * 0.8f;
#pragma unroll
  for (int vt = 0; vt < 8; ++vt) {
    const int vd = vt * 16 + fg * 4;
    const f32x4 g4 = *(const f32x4*)(p.subln + vd);
    st_bf4(YC + (size_t)(q0 + fr) * 1024 + h * 128 + vd, o[0][vt] * g4 * rs);
  }
}


#ifndef STOP
#define STOP 99
#endif
DI void digest(const Params& p, int which, int bid, int nb, int tid) {
  const unsigned char* ws = p.ws;
  for (size_t i = (size_t)bid * 512 + tid; i < (size_t)T * 1024; i += (size_t)nb * 512) {
    const size_t t = i >> 10; const int c = (int)(i & 1023);
    float v = 0.f;
    if (which == 3) {
      v = bf2f(((const bf16_t*)(ws + O_QK))[i]);
      if (c < 512) {
        const size_t o = t * 512 + c;
        v += bf2f(((const bf16_t*)(ws + O_VT))[o]) + bf2f(((const bf16_t*)(ws + O_RS))[o]) + bf2f(((const bf16_t*)(ws + O_KS))[o]) +
             bf2f(((const bf16_t*)(ws + O_VS))[o]) + bf2f(((const bf16_t*)(ws + O_KK))[o]) + bf2f(((const bf16_t*)(ws + O_E0))[o]) +
             bf2f(((const bf16_t*)(ws + O_E1))[o]) + bf2f(((const bf16_t*)(ws + O_A0))[o]) + bf2f(((const bf16_t*)(ws + O_A1))[o]) +
             bf2f(((const bf16_t*)(ws + O_GG))[o]);
      }
    } else if (which == 0) {
      v = bf2f(((const bf16_t*)(ws + O_XB))[i]) + ((const float*)(ws + O_RSTD1))[t] + bf2f(((const bf16_t*)(ws + O_WINT))[i % (size_t)(3456 * 1024)]) +
          bf2f(((const bf16_t*)(ws + O_WUPT))[i % (size_t)(5632 * 1024)]) + bf2f(((const bf16_t*)(ws + O_WDOWNT))[i % (size_t)(2816 * 1024)]) +
          bf2f(((const bf16_t*)(ws + O_WOUTT))[i % (size_t)(1024 * 1024)]) + bf2f(((const bf16_t*)(ws + O_W2T))[i % (size_t)(196608)]) +
          ((const float*)(ws + O_ROPE))[i % (size_t)(8192 * 64)];
    } else if (which == 1) {
      v = bf2f(((const bf16_t*)(ws + O_QK))[i]);
      if (c < 512) v += bf2f(((const bf16_t*)(ws + O_VT))[t * 512 + c]);
      v += bf2f(((const bf16_t*)(ws + O_Z))[t * 1920 + c]);
      if (c < 896) v += bf2f(((const bf16_t*)(ws + O_Z))[t * 1920 + 1024 + c]);
    } else if (which == 2) {
      if (c < 512) {
        const size_t o = t * 512 + c;
        v = bf2f(((const bf16_t*)(ws + O_RS))[o]) + bf2f(((const bf16_t*)(ws + O_KS))[o]) + bf2f(((const bf16_t*)(ws + O_VS))[o]) + bf2f(((const bf16_t*)(ws + O_KK))[o]);
      } else if (c < 896) v = bf2f(((const bf16_t*)(ws + O_LIN))[t * 384 + c - 512]);
    } else if (which == 6) {
      v = bf2f(((const bf16_t*)(ws + O_YCAT))[i]);
    }
    p.out[i] = v;
  }
}

__global__ void __launch_bounds__(512) mega(Params p) {
  cg::grid_group grid = cg::this_grid();
  extern __shared__ __attribute__((aligned(16))) unsigned char lds[];
  __shared__ int s_item;
  const int tid = threadIdx.x, bid = blockIdx.x, nb = gridDim.x, lane = tid & 63, wave = tid >> 6;
  const int gw = bid * 8 + wave, ngw = nb * 8;
  unsigned char* ws = p.ws;
  float* rstd1 = (float*)(ws + O_RSTD1);
  float* rstd2 = (float*)(ws + O_RSTD2);
  float* misc = (float*)(ws + O_MISC);

  {
    bf16_t* xb = (bf16_t*)(ws + O_XB);
    for (int row = gw; row < T; row += ngw) {
      const f32x4* xr = (const f32x4*)(p.x + (size_t)row * D) + lane;
      f32x4 v[4];
      float s = 0.f;
#pragma unroll
      for (int j = 0; j < 4; ++j) {
        v[j] = xr[64 * j];
        s += v[j][0] * v[j][0] + v[j][1] * v[j][1] + v[j][2] * v[j][2] + v[j][3] * v[j][3];
      }
      s = wave_sum(s);
      if (lane == 0) rstd1[row] = rsqrtf(s * (1.f / D) + 1e-6f);
      bf16_t* orow = xb + (size_t)row * D + lane * 4;
#pragma unroll
      for (int j = 0; j < 4; ++j) st_bf4(orow + 256 * j, v[j]);
    }
    float* tile = (float*)lds;
    transpose_job(p.w_in, D, NIN, (bf16_t*)(ws + O_WINT), p.pre_mix, true, tile, bid, nb, tid);
    transpose_job(p.w_out, D, D, (bf16_t*)(ws + O_WOUTT), nullptr, false, tile, bid, nb, tid);
    transpose_job(p.w_up, D, 2 * DFF, (bf16_t*)(ws + O_WUPT), p.pre_ffn, false, tile, bid, nb, tid);
    transpose_job(p.w_down, DFF, D, (bf16_t*)(ws + O_WDOWNT), nullptr, false, tile, bid, nb, tid);
    transpose_job(p.w2, 64, 512, (bf16_t*)(ws + O_W2T), nullptr, false, tile, bid, nb, tid);
    transpose_job(p.w2 + 64 * 512, 64, 512, (bf16_t*)(ws + O_W2T) + 512 * 64, nullptr, false, tile, bid, nb, tid);
    transpose_job(p.a2, 64, 512, (bf16_t*)(ws + O_A2T), nullptr, false, tile, bid, nb, tid);
    transpose_job(p.a2 + 64 * 512, 64, 512, (bf16_t*)(ws + O_A2T) + 512 * 64, nullptr, false, tile, bid, nb, tid);
    transpose_job(p.g2, 128, 512, (bf16_t*)(ws + O_G2T), nullptr, false, tile, bid, nb, tid);
    f32x2* rope = (f32x2*)(ws + O_ROPE);
    for (int i = bid * 512 + tid; i < S * 32; i += nb * 512) {
      const int s = i >> 5, f = i & 31;
      const float inv = powf(10000.f, -(float)f / 32.f);
      const float ang = (float)s * inv;
      rope[i] = (f32x2){cosf(ang), sinf(ang)};
    }
    if (bid == 0 && tid == 0) {
      float s1 = 0.f, s2 = 0.f;
      for (int i = 0; i < 64; ++i) {
        s1 += p.lq1[i] * p.lk1[i];
        s2 += p.lq2[i] * p.lk2[i];
      }
      misc[0] = expf(s1) - expf(s2) + 0.2f;
      ((int*)misc)[1] = 0;
    }
  }
  grid.sync();
  if (STOP == 0) { digest(p, 0, bid, nb, tid); return; }

  {
    const bf16_t* xb = (const bf16_t*)(ws + O_XB);
    const bf16_t* wt = (const bf16_t*)(ws + O_WINT);
    EpiInProj e1{rstd1, (const f32x2*)(ws + O_ROPE), (bf16_t*)(ws + O_QK), (bf16_t*)(ws + O_Z)};
    EpiV ev{rstd1, (bf16_t*)(ws + O_VT)};
    const int total = 256 * 27, per = (total + nb - 1) / nb, lo = bid * per, hi = min(total, lo + per);
    for (int it = lo; it < hi; ++it) {
      const int mt = it / 27, nt = it % 27;
      if (nt >= 8 && nt < 12) gemm_tile<true>(xb, D, wt, D, D, mt * 256, nt * 128, lds, ev, tid);
      else gemm_tile<false>(xb, D, wt, D, D, mt * 256, nt * 128, lds, e1, tid);
    }
  }
  grid.sync();
  if (STOP == 1) { digest(p, 1, bid, nb, tid); return; }

  {
    const bf16_t* Z = (const bf16_t*)(ws + O_Z);
    bf16_t* RS = (bf16_t*)(ws + O_RS);
    bf16_t* KS = (bf16_t*)(ws + O_KS);
    bf16_t* VS = (bf16_t*)(ws + O_VS);
    bf16_t* KK = (bf16_t*)(ws + O_KK);
    bf16_t* LIN = (bf16_t*)(ws + O_LIN);
    for (int t = gw; t < T; t += ngw) {
      const int s = t & (S - 1);
      const bool hp = s > 0, hn = s < S - 1;
      const bf16_t* zc = Z + (size_t)t * NRW;
#pragma unroll 3
      for (int it = 0; it < 15; ++it) {
        const int c = it * 128 + lane * 2;
        const u32 z0 = *(const u32*)(zc + c);
        const u32 zp = hp ? *(const u32*)(zc + c - NRW) : 0u;
        const u32 zn = hn ? *(const u32*)(zc + c + NRW) : 0u;
        const f32x2 m = *(const f32x2*)(p.mu + c);
        const float a0 = bflo(z0), a1 = bfhi(z0);
        const float v0 = a0 + (0.5f * (bflo(zp) + bflo(zn)) - a0) * m.x;
        const float v1 = a1 + (0.5f * (bfhi(zp) + bfhi(zn)) - a1) * m.y;
        if (it < 4) {
          *(u32*)(RS + (size_t)t * 512 + c) = pk2(v0, v1);
        } else if (it < 8) {
          const int cc = c - 512;
          *(u32*)(KS + (size_t)t * 512 + cc) = pk2(v0, v1);
          const f32x2 kk = *(const f32x2*)(p.k_k + cc);
          const float f0 = v0 * kk.x, f1 = v1 * kk.y;
          float ss = f0 * f0 + f1 * f1;
#pragma unroll
          for (int o = 1; o < 32; o <<= 1) ss += __shfl_xor(ss, o);
          const float rn = rsqrtf(fmaxf(ss, 1e-12f));
          *(u32*)(KK + (size_t)t * 512 + cc) = pk2(f0 * rn, f1 * rn);
        } else if (it < 12) {
          *(u32*)(VS + (size_t)t * 512 + (c - 1024)) = pk2(v0, v1);
        } else if (it == 12) {
          *(u32*)(LIN + (size_t)t * 384 + (c - 1536)) = pk2(tanhf(v0), tanhf(v1));
        } else if (it == 13) {
          *(u32*)(LIN + (size_t)t * 384 + (c - 1536)) = pk2(v0, v1);
        } else {
          *(u32*)(LIN + (size_t)t * 384 + (c - 1536)) = pk2(sigmoidf_(v0), sigmoidf_(v1));
        }
      }
    }
  }
  grid.sync();
  if (STOP == 2) { digest(p, 2, bid, nb, tid); return; }

  {
    const bf16_t* LIN = (const bf16_t*)(ws + O_LIN);
    const bf16_t* W2T = (const bf16_t*)(ws + O_W2T);
    const bf16_t* A2T = (const bf16_t*)(ws + O_A2T);
    const bf16_t* G2T = (const bf16_t*)(ws + O_G2T);
    for (int d = 0; d < 2; ++d) {
      EpiLora ee{0, p.w0 + d * 512, (bf16_t*)(ws + (d ? O_E1 : O_E0))};
      gemm_phase<false>(LIN + d * 64, 384, W2T + d * 512 * 64, 64, 64, 4, 0, 4, lds, ee, bid, nb, tid);
      EpiLora ea{1, p.a0 + d * 512, (bf16_t*)(ws + (d ? O_A1 : O_A0))};
      gemm_phase<false>(LIN + 128 + d * 64, 384, A2T + d * 512 * 64, 64, 64, 4, 0, 4, lds, ea, bid, nb, tid);
    }
    EpiLora eg{2, nullptr, (bf16_t*)(ws + O_GG)};
    gemm_phase<false>(LIN + 256, 384, G2T, 128, 128, 4, 0, 4, lds, eg, bid, nb, tid);
  }
  grid.sync();
  if (STOP == 3) { digest(p, 3, bid, nb, tid); return; }

  {
    const float lam = misc[0];
    int* counter = (int*)misc + 1;
    for (;;) {
      if (tid == 0) s_item = atomicAdd(counter, 1);
      __syncthreads();
      const int item = s_item;
      __syncthreads();
      if (item >= 128 + 2048) break;
      if (item < 128) scan_chain(p, item, lds, tid);
      else attn_item(p, item - 128, lam, lds, tid);
    }
  }
  grid.sync();

  {
    const float* Y0 = p.out;
    const float* Y1 = p.out + (size_t)T * 512;
    const bf16_t* RS = (const bf16_t*)(ws + O_RS);
    const bf16_t* KS = (const bf16_t*)(ws + O_KS);
    const bf16_t* VS = (const bf16_t*)(ws + O_VS);
    const bf16_t* A0 = (const bf16_t*)(ws + O_A0);
    const bf16_t* A1 = (const bf16_t*)(ws + O_A1);
    const bf16_t* GG = (const bf16_t*)(ws + O_GG);
    bf16_t* YC = (bf16_t*)(ws + O_YCAT);
    for (int idx = gw; idx < T * 8; idx += ngw) {
      const int t = idx >> 3, h = idx & 7, c = h * 64 + lane;
      const size_t o = (size_t)t * 512 + c;
      const float y = Y0[o] + Y1[o];
      const float mean = wave_sum(y) * (1.f / 64.f);
      const float dl = y - mean;
      const float var = wave_sum(dl * dl) * (1.f / 64.f);
      const float yn = dl * rsqrtf(var + 64e-5f) * p.gn_w[c] + p.gn_b[c];
      const float r = bf2f(RS[o]), k = bf2f(KS[o]), v = bf2f(VS[o]), a0 = bf2f(A0[o]), a1 = bf2f(A1[o]), g = bf2f(GG[o]);
      const float ka = p.k_a[c];
      const float kd = k * (2.f + (a0 + a1 - 2.f) * ka);
      const float bs = wave_sum(r * kd * p.r_k[c]);
      YC[(size_t)t * 1024 + 512 + c] = f2bf((yn + bs * v) * g);
    }
  }
  grid.sync();
  if (STOP == 6) { digest(p, 6, bid, nb, tid); return; }

  {
    EpiF32 e{(float*)(ws + O_MIX), D};
    gemm_phase<false>((const bf16_t*)(ws + O_YCAT), D, (const bf16_t*)(ws + O_WOUTT), D, D, 8, 0, 8, lds, e, bid, nb, tid);
  }
  grid.sync();

  {
    const float* mix = (const float*)(ws + O_MIX);
    bf16_t* x1b = (bf16_t*)(ws + O_X1B);
    for (int row = gw; row < T; row += ngw) {
      const f32x4* mr = (const f32x4*)(mix + (size_t)row * D) + lane;
      const f32x4* xr = (const f32x4*)(p.x + (size_t)row * D) + lane;
      const f32x4* gr = (const f32x4*)(p.post_mix) + lane;
      f32x4 mv[4];
      float s = 0.f;
#pragma unroll
      for (int j = 0; j < 4; ++j) {
        mv[j] = mr[64 * j];
        s += mv[j][0] * mv[j][0] + mv[j][1] * mv[j][1] + mv[j][2] * mv[j][2] + mv[j][3] * mv[j][3];
      }
      const float rs = rsqrtf(wave_sum(s) * (1.f / D) + 1e-6f);
      float s2 = 0.f;
      f32x4* orow = (f32x4*)(p.out + (size_t)row * D) + lane;
#pragma unroll
      for (int j = 0; j < 4; ++j) {
        mv[j] = xr[64 * j] + mv[j] * rs * gr[64 * j];
        s2 += mv[j][0] * mv[j][0] + mv[j][1] * mv[j][1] + mv[j][2] * mv[j][2] + mv[j][3] * mv[j][3];
        orow[64 * j] = mv[j];
        st_bf4(x1b + (size_t)row * D + lane * 4 + 256 * j, mv[j]);
      }
      s2 = wave_sum(s2);
      if (lane == 0) rstd2[row] = rsqrtf(s2 * (1.f / D) + 1e-6f);
    }
  }
  grid.sync();

  {
    EpiGate e{rstd2, (bf16_t*)(ws + O_G)};
    gemm_phase<false>((const bf16_t*)(ws + O_X1B), D, (const bf16_t*)(ws + O_WUPT), D, D, 22, 0, 22, lds, e, bid, nb, tid);
  }
  grid.sync();

  {
    EpiUp e{rstd2, (const bf16_t*)(ws + O_G), p.conv_w, p.conv_b, (bf16_t*)(ws + O_ACT)};
    gemm_phase<false>((const bf16_t*)(ws + O_X1B), D, (const bf16_t*)(ws + O_WUPT) + (size_t)DFF * D, D, D, 22, 0, 22, lds, e, bid, nb, tid);
  }
  grid.sync();

  {
    EpiF32 e{(float*)(ws + O_F), D};
    gemm_phase<false>((const bf16_t*)(ws + O_ACT), DFF, (const bf16_t*)(ws + O_WDOWNT), DFF, DFF, 8, 0, 8, lds, e, bid, nb, tid);
  }
  grid.sync();

  {
    const float* f = (const float*)(ws + O_F);
    for (int row = gw; row < T; row += ngw) {
      const f32x4* fr_ = (const f32x4*)(f + (size_t)row * D) + lane;
      const f32x4* gr = (const f32x4*)(p.post_ffn) + lane;
      f32x4* orow = (f32x4*)(p.out + (size_t)row * D) + lane;
      f32x4 fv[4];
      float s = 0.f;
#pragma unroll
      for (int j = 0; j < 4; ++j) {
        fv[j] = fr_[64 * j];
        s += fv[j][0] * fv[j][0] + fv[j][1] * fv[j][1] + fv[j][2] * fv[j][2] + fv[j][3] * fv[j][3];
      }
      const float rs = rsqrtf(wave_sum(s) * (1.f / D) + 1e-6f);
#pragma unroll
      for (int j = 0; j < 4; ++j) orow[64 * j] = orow[64 * j] + fv[j] * rs * gr[64 * j];
    }
  }
}

extern "C" void kernel_launch(void* const* d_in, const int* in_sizes, int n_in, void* d_out, int out_size, void* d_ws, size_t ws_size,
                              hipStream_t stream) {
  static int grid_blocks = 0;
  if (grid_blocks == 0) {
    if (n_in != 27 || in_sizes[0] != T * D || out_size != T * D || ws_size < WS_END) {
      fprintf(stderr, "kernel_launch: unexpected shapes (n_in %d, in0 %d, out %d, ws %zu)\n", n_in, n_in > 0 ? in_sizes[0] : -1, out_size, ws_size);
      grid_blocks = -1;
      return;
    }
    int dev = 0, cus = 0, per_cu = 0;
    (void)hipGetDevice(&dev);
    (void)hipDeviceGetAttribute(&cus, hipDeviceAttributeMultiprocessorCount, dev);
    (void)hipFuncSetAttribute((const void*)mega, hipFuncAttributeMaxDynamicSharedMemorySize, LDS_BYTES);
    (void)hipOccupancyMaxActiveBlocksPerMultiprocessor(&per_cu, (const void*)mega, 512, LDS_BYTES);
    if (per_cu < 1) per_cu = 1;
    grid_blocks = cus * per_cu;
  }
  if (grid_blocks < 0) return;
  Params p{};
  const float** pp = (const float**)&p;
  for (int i = 0; i < 27; ++i) pp[i] = (const float*)d_in[i];
  p.out = (float*)d_out;
  p.ws = (unsigned char*)d_ws;
  void* args[] = {&p};
  hipError_t e = hipLaunchCooperativeKernel((const void*)mega, dim3(grid_blocks), dim3(512), args, LDS_BYTES, stream);
  if (e != hipSuccess) fprintf(stderr, "cooperative launch failed: %s (grid %d)\n", hipGetErrorString(e), grid_blocks);
}
```

```cpp
#include <hip/hip_runtime.h>
#include <hip/hip_cooperative_groups.h>
#include <cstdio>
namespace cg = cooperative_groups;

typedef unsigned short bf16_t;
typedef short bf16x8 __attribute__((ext_vector_type(8)));
typedef float f32x4 __attribute__((ext_vector_type(4)));
typedef float f32x2 __attribute__((ext_vector_type(2)));
typedef unsigned int u32;
typedef u32 u32x4 __attribute__((ext_vector_type(4)));
typedef u32 u32x2 __attribute__((ext_vector_type(2)));

#define DI __device__ __forceinline__

constexpr int T = 65536, S = 8192, D = 1024, NIN = 3456, NRW = 1920, DFF = 2816;
constexpr size_t MiB = 1ull << 20;
constexpr size_t O_WINT = 0, O_WOUTT = 7 * MiB, O_WUPT = 9 * MiB, O_WDOWNT = 20 * MiB;
constexpr size_t O_W2T = 26 * MiB, O_A2T = O_W2T + 131072, O_G2T = O_W2T + 262144;
constexpr size_t O_ROPE = 27 * MiB, O_RSTD1 = 29 * MiB, O_RSTD2 = O_RSTD1 + 262144, O_MISC = 30 * MiB;
constexpr size_t O_XB = 32 * MiB, O_LIN = 32 * MiB, O_YCAT = 32 * MiB, O_ACT = 32 * MiB;
constexpr size_t O_QK = 160 * MiB, O_VT = 288 * MiB, O_MIX = 160 * MiB;
constexpr size_t O_Z = 352 * MiB, O_E0 = 352 * MiB, O_E1 = 416 * MiB, O_A0 = 480 * MiB, O_A1 = 544 * MiB, O_GG = 608 * MiB;
constexpr size_t O_RS = 672 * MiB, O_KS = 736 * MiB, O_VS = 800 * MiB, O_KK = 864 * MiB;
constexpr size_t O_X1B = 416 * MiB, O_G = 544 * MiB, O_F = 544 * MiB;
constexpr size_t WS_END = 928 * MiB;

constexpr int LDS_BYTES = 114688;
constexpr float QSCALE = 0.125f * 1.4426950408889634f;

struct Params {
  const float *x, *pre_mix, *post_mix, *pre_ffn, *post_ffn, *w_in, *lq1, *lk1, *lq2, *lk2, *subln, *mu, *w0, *w2, *a0, *a2, *g2,
      *k_k, *k_a, *r_k, *gn_w, *gn_b, *w_out, *w_up, *conv_w, *conv_b, *w_down;
  float* out;
  unsigned char* ws;
};

typedef __bf16 bf16x2_t __attribute__((ext_vector_type(2)));
DI u32 pk2(float lo, float hi) {
  f32x2 f = {lo, hi};
  bf16x2_t b = __builtin_convertvector(f, bf16x2_t);
  return __builtin_bit_cast(u32, b);
}
DI bf16_t f2bf(float f) { return (bf16_t)(pk2(f, 0.f) & 0xffffu); }
DI float bf2f(u32 h) { return __uint_as_float(h << 16); }
DI float bflo(u32 w) { return __uint_as_float(w << 16); }
DI float bfhi(u32 w) { return __uint_as_float(w & 0xffff0000u); }
DI void st_bf4(bf16_t* p, f32x4 v) {
  u32x2 o;
  o.x = pk2(v[0], v[1]);
  o.y = pk2(v[2], v[3]);
  *(u32x2*)p = o;
}
DI float wave_sum(float v) {
#pragma unroll
  for (int o = 1; o < 64; o <<= 1) v += __shfl_xor(v, o);
  return v;
}
DI float sigmoidf_(float u) { return 1.f / (1.f + __expf(-u)); }
template <int CTRL>
DI float dppf(float v) {
  return __builtin_bit_cast(float, __builtin_amdgcn_update_dpp(0, __builtin_bit_cast(int, v), CTRL, 0xF, 0xF, true));
}
DI float row_sum16(float v) {
  v += dppf<0x128>(v);
  v += dppf<0x124>(v);
  v += dppf<0x122>(v);
  v += dppf<0x121>(v);
  return v;
}


DI void gsync(unsigned* bar, unsigned target) {
  __threadfence();
  __syncthreads();
  if (threadIdx.x == 0) {
    __hip_atomic_fetch_add(bar, 1u, __ATOMIC_RELEASE, __HIP_MEMORY_SCOPE_AGENT);
    while (__hip_atomic_load(bar, __ATOMIC_RELAXED, __HIP_MEMORY_SCOPE_AGENT) < target) __builtin_amdgcn_s_sleep(2);
  }
  __syncthreads();
  __builtin_amdgcn_fence(__ATOMIC_ACQUIRE, "agent");
}

DI void transpose_job(const float* src, int K, int N, bf16_t* dst, const float* g, bool perm, float* tile, int bid, int nb, int tid) {
  const int nnt = N / 64, nit = (K / 64) * nnt;
  for (int it = bid; it < nit; it += nb) {
    const int kt = it / nnt, nt = it % nnt, k0 = kt * 64, n0 = nt * 64;
#pragma unroll
    for (int i = 0; i < 8; ++i) {
      const int kk = (tid >> 6) + 8 * i, nn = tid & 63;
      float v = src[(size_t)(k0 + kk) * N + n0 + nn];
      if (g) v *= g[k0 + kk];
      tile[kk * 65 + nn] = v;
    }
    __syncthreads();
#pragma unroll
    for (int i = 0; i < 8; ++i) {
      const int nn = (tid >> 6) + 8 * i, kk = tid & 63;
      const int n = n0 + nn;
      int nd = n;
      if (perm && n < 1024) {
        const int d = n & 63;
        nd = (n & ~63) | (2 * (d & 31) + (d >> 5));
      }
      dst[(size_t)nd * K + k0 + kk] = f2bf(tile[kk * 65 + nn]);
    }
    __syncthreads();
  }
}

constexpr int G_ASTAGE = 256 * 128, G_BSTAGE = 128 * 128, G_STAGE = G_ASTAGE + G_BSTAGE;

template <bool SWAP, class Epi>
DI void gemm_tile(const bf16_t* __restrict__ A, int lda, const bf16_t* __restrict__ Bt, int ldb, int K, int m0, int n0,
                  unsigned char* lds, const Epi& epi, int tid) {
  const int lane = tid & 63, wave = tid >> 6, wm = wave >> 1, wn = wave & 1, fr = lane & 15, fg = lane >> 4;
  f32x4 acc[4][4];
#pragma unroll
  for (int i = 0; i < 4; ++i)
#pragma unroll
    for (int j = 0; j < 4; ++j) acc[i][j] = (f32x4){0.f, 0.f, 0.f, 0.f};
  const int nk = K / 64;
  const int srow = tid >> 3, skc = tid & 7;
  const int swo = ((skc ^ ((srow >> 1) & 7)) * 16);
  const int frs = (fr >> 1) & 7;
  const bf16_t* ga = A + (size_t)(m0 + srow) * lda + skc * 8;
  const bf16_t* gb = Bt + (size_t)(n0 + srow) * ldb + skc * 8;
  u32x4 ra[4], rb[2];
#pragma unroll
  for (int i = 0; i < 4; ++i) ra[i] = *(const u32x4*)(ga + (size_t)(64 * i) * lda);
#pragma unroll
  for (int i = 0; i < 2; ++i) rb[i] = *(const u32x4*)(gb + (size_t)(64 * i) * ldb);
  {
    unsigned char* as = lds;
    unsigned char* bs = lds + G_ASTAGE;
#pragma unroll
    for (int i = 0; i < 4; ++i) *(u32x4*)(as + (srow + 64 * i) * 128 + swo) = ra[i];
#pragma unroll
    for (int i = 0; i < 2; ++i) *(u32x4*)(bs + (srow + 64 * i) * 128 + swo) = rb[i];
  }
  __syncthreads();
  for (int kt = 0; kt < nk; ++kt) {
    const bool more = (kt + 1 < nk);
    if (more) {
#pragma unroll
      for (int i = 0; i < 4; ++i) ra[i] = *(const u32x4*)(ga + (size_t)(64 * i) * lda + (kt + 1) * 64);
#pragma unroll
      for (int i = 0; i < 2; ++i) rb[i] = *(const u32x4*)(gb + (size_t)(64 * i) * ldb + (kt + 1) * 64);
    }
    const unsigned char* as = lds + (kt & 1) * G_STAGE;
    const unsigned char* bs = as + G_ASTAGE;
#pragma unroll
    for (int ks = 0; ks < 2; ++ks) {
      bf16x8 af[4], bfr[4];
#pragma unroll
      for (int i = 0; i < 4; ++i) af[i] = *(const bf16x8*)(as + (wm * 64 + i * 16 + fr) * 128 + (((ks * 4 + fg) ^ frs) * 16));
#pragma unroll
      for (int i = 0; i < 4; ++i) bfr[i] = *(const bf16x8*)(bs + (wn * 64 + i * 16 + fr) * 128 + (((ks * 4 + fg) ^ frs) * 16));
#pragma unroll
      for (int mi = 0; mi < 4; ++mi)
#pragma unroll
        for (int ni = 0; ni < 4; ++ni) {
          if (SWAP) acc[mi][ni] = __builtin_amdgcn_mfma_f32_16x16x32_bf16(af[mi], bfr[ni], acc[mi][ni], 0, 0, 0);
          else acc[mi][ni] = __builtin_amdgcn_mfma_f32_16x16x32_bf16(bfr[ni], af[mi], acc[mi][ni], 0, 0, 0);
        }
    }
    if (more) {
      unsigned char* as2 = lds + ((kt + 1) & 1) * G_STAGE;
      unsigned char* bs2 = as2 + G_ASTAGE;
#pragma unroll
      for (int i = 0; i < 4; ++i) *(u32x4*)(as2 + (srow + 64 * i) * 128 + swo) = ra[i];
#pragma unroll
      for (int i = 0; i < 2; ++i) *(u32x4*)(bs2 + (srow + 64 * i) * 128 + swo) = rb[i];
    }
    __syncthreads();
  }
#pragma unroll
  for (int mi = 0; mi < 4; ++mi)
#pragma unroll
    for (int ni = 0; ni < 4; ++ni) {
      if (SWAP) epi(m0 + wm * 64 + mi * 16 + fg * 4, n0 + wn * 64 + ni * 16 + fr, acc[mi][ni]);
      else epi(m0 + wm * 64 + mi * 16 + fr, n0 + wn * 64 + ni * 16 + fg * 4, acc[mi][ni]);
    }
}

struct EpiInProj {
  const float* rstd; const f32x2* rope; bf16_t* qk; bf16_t* z;
  DI void operator()(int m, int n, f32x4 v) const {
    const float rs = rstd[m];
    v = v * rs;
    if (n < 1024) {
      const int s = m & (S - 1), i = (n & 63) >> 1;
      const f32x2 c0 = rope[s * 32 + i], c1 = rope[s * 32 + i + 1];
      float a = v[0], b = v[1];
      v[0] = a * c0.x - b * c0.y; v[1] = b * c0.x + a * c0.y;
      a = v[2]; b = v[3];
      v[2] = a * c1.x - b * c1.y; v[3] = b * c1.x + a * c1.y;
      if (n < 512) v = v * QSCALE;
      st_bf4(qk + (size_t)m * 1024 + n, v);
    } else {
      st_bf4(z + (size_t)m * NRW + (n - 1536), v);
    }
  }
};
struct EpiV {
  const float* rstd; bf16_t* vt;
  DI void operator()(int m, int n, f32x4 v) const {
    const f32x4 rs = *(const f32x4*)(rstd + m);
    v = v * rs;
    const int nn = n - 1024, h = nn >> 7, vd = nn & 127, b = m >> 13, s = m & (S - 1);
    st_bf4(vt + ((size_t)((b * 4 + h) * 128 + vd)) * S + s, v);
  }
};
struct EpiLora {
  int mode; const float* bias; bf16_t* out;
  DI void operator()(int m, int n, f32x4 v) const {
    if (mode < 2) {
      const f32x4 bv = *(const f32x4*)(bias + n);
      const float sc = mode == 0 ? 0.60653065971f : 1.f;
#pragma unroll
      for (int j = 0; j < 4; ++j) v[j] = sc * sigmoidf_(v[j] + bv[j]);
    }
    st_bf4(out + (size_t)m * 512 + n, v);
  }
};
struct EpiF32 {
  float* out; int ld;
  DI void operator()(int m, int n, f32x4 v) const { *(f32x4*)(out + (size_t)m * ld + n) = v; }
};
struct EpiGate {
  const float* rstd; bf16_t* g;
  DI void operator()(int m, int n, f32x4 v) const { st_bf4(g + (size_t)m * DFF + n, v * rstd[m]); }
};
struct EpiUp {
  const float* rstd; const bf16_t* g; const float* cw; const float* cb; bf16_t* act;
  DI void operator()(int m, int n, f32x4 v) const {
    v = v * rstd[m];
    const int s = m & (S - 1);
    const bf16_t* gp = g + (size_t)m * DFF + n;
    const u32x2 g0 = *(const u32x2*)gp;
    u32x2 gm = (u32x2){0u, 0u}, gn = (u32x2){0u, 0u};
    if (s > 0) gm = *(const u32x2*)(gp - DFF);
    if (s < S - 1) gn = *(const u32x2*)(gp + DFF);
    const f32x4 w0 = *(const f32x4*)(cw + n), w1 = *(const f32x4*)(cw + DFF + n), w2 = *(const f32x4*)(cw + 2 * DFF + n), bb = *(const f32x4*)(cb + n);
    f32x4 c, p, q;
    c[0] = bflo(g0.x); c[1] = bfhi(g0.x); c[2] = bflo(g0.y); c[3] = bfhi(g0.y);
    p[0] = bflo(gm.x); p[1] = bfhi(gm.x); p[2] = bflo(gm.y); p[3] = bfhi(gm.y);
    q[0] = bflo(gn.x); q[1] = bfhi(gn.x); q[2] = bflo(gn.y); q[3] = bfhi(gn.y);
    f32x4 o;
#pragma unroll
    for (int j = 0; j < 4; ++j) {
      const float xg = w0[j] * p[j] + w1[j] * c[j] + w2[j] * q[j] + bb[j];
      const float y = 0.7978845608028654f * (xg + 0.044715f * xg * xg * xg);
      o[j] = xg / (1.f + __expf(-2.f * y)) * v[j];
    }
    st_bf4(act + (size_t)m * DFF + n, o);
  }
};

template <bool SWAP, class Epi>
DI void gemm_phase(const bf16_t* A, int lda, const bf16_t* Bt, int ldb, int K, int ntn, int nt_lo, int nt_hi, unsigned char* lds, const Epi& epi,
                   int bid, int nb, int tid) {
  const int w = nt_hi - nt_lo, total = 256 * w, per = (total + nb - 1) / nb;
  const int lo = bid * per, hi = min(total, lo + per);
  for (int it = lo; it < hi; ++it) {
    const int mt = it / w, nt = nt_lo + it % w;
    gemm_tile<SWAP>(A, lda, Bt, ldb, K, mt * 256, nt * 128, lds, epi, tid);
  }
}

DI void scan_chain(const Params& p, int chain, unsigned char* lds, int tid) {
  const int d = chain & 1, h = (chain >> 1) & 7, b = chain >> 4;
  float* rec = (float*)lds;
  float* ybuf = (float*)(lds + 98304);
  const bf16_t* RS = (const bf16_t*)(p.ws + O_RS);
  const bf16_t* KS = (const bf16_t*)(p.ws + O_KS);
  const bf16_t* VS = (const bf16_t*)(p.ws + O_VS);
  const bf16_t* KK = (const bf16_t*)(p.ws + O_KK);
  const bf16_t* EE = (const bf16_t*)(p.ws + (d ? O_E1 : O_E0));
  const bf16_t* AA = (const bf16_t*)(p.ws + (d ? O_A1 : O_A0));
  float* Y = p.out + (size_t)d * T * 512;
  const int lane = tid & 63, wave = tid >> 6, cgi = lane & 15, rg = lane >> 4, row0 = wave * 8 + rg * 2;
  const float ka = p.k_a[h * 64 + lane];
  float S0[4] = {0.f, 0.f, 0.f, 0.f}, S1[4] = {0.f, 0.f, 0.f, 0.f};
  bf16_t pr[4][6];
  const int ch = h * 64 + lane;
#define SCAN_TOK(n, k) ((size_t)(b * S + (d ? (S - 1 - ((n) * 32 + (k))) : ((n) * 32 + (k)))))
#define SCAN_LOAD(n)                                                      \
  _Pragma("unroll") for (int i = 0; i < 4; ++i) {                         \
    const size_t o_ = SCAN_TOK(n, wave + 8 * i) * 512 + ch;               \
    pr[i][0] = RS[o_]; pr[i][1] = KS[o_]; pr[i][2] = VS[o_];              \
    pr[i][3] = KK[o_]; pr[i][4] = EE[o_]; pr[i][5] = AA[o_];              \
  }
#define SCAN_XFORM(buf)                                                   \
  _Pragma("unroll") for (int i = 0; i < 4; ++i) {                         \
    float* R_ = rec + (buf) * 12288 + (wave + 8 * i) * 384 + lane;        \
    const float r_ = bf2f(pr[i][0]), k_ = bf2f(pr[i][1]), v_ = bf2f(pr[i][2]), kk_ = bf2f(pr[i][3]), e_ = bf2f(pr[i][4]), a_ = bf2f(pr[i][5]); \
    R_[0] = __expf(-e_); R_[64] = kk_; R_[128] = kk_ * a_; R_[192] = k_ * (1.f + (a_ - 1.f) * ka); R_[256] = r_; R_[320] = v_; \
  }
  SCAN_LOAD(0);
  SCAN_XFORM(0);
  __syncthreads();
  for (int n = 0; n < 256; ++n) {
    if (n + 1 < 256) { SCAN_LOAD(n + 1); }
    const float* RB = rec + (n & 1) * 12288;
    float* YB = ybuf + (n & 1) * 2048;
#pragma unroll 4
    for (int k = 0; k < 32; ++k) {
      const float* R = RB + k * 384;
      const f32x4 w4 = *(const f32x4*)(R + cgi * 4), kk4 = *(const f32x4*)(R + 64 + cgi * 4), b4 = *(const f32x4*)(R + 128 + cgi * 4),
                  kd4 = *(const f32x4*)(R + 192 + cgi * 4), r4 = *(const f32x4*)(R + 256 + cgi * 4);
      const f32x2 v2 = *(const f32x2*)(R + 320 + row0);
      float d0 = S0[0] * kk4[0] + S0[1] * kk4[1] + S0[2] * kk4[2] + S0[3] * kk4[3];
      float d1 = S1[0] * kk4[0] + S1[1] * kk4[1] + S1[2] * kk4[2] + S1[3] * kk4[3];
      d0 = row_sum16(d0);
      d1 = row_sum16(d1);
      float y0 = 0.f, y1 = 0.f;
#pragma unroll
      for (int c = 0; c < 4; ++c) {
        S0[c] = S0[c] * w4[c] + (v2.x * kd4[c] - d0 * b4[c]);
        S1[c] = S1[c] * w4[c] + (v2.y * kd4[c] - d1 * b4[c]);
        y0 += S0[c] * r4[c];
        y1 += S1[c] * r4[c];
      }
      y0 = row_sum16(y0);
      y1 = row_sum16(y1);
      if (cgi == 0) *(f32x2*)(YB + k * 64 + row0) = (f32x2){y0, y1};
    }
    if (n + 1 < 256) { SCAN_XFORM((n + 1) & 1); }
    __syncthreads();
    {
      const int k = tid >> 4, c4 = (tid & 15) * 4;
      *(f32x4*)(Y + SCAN_TOK(n, k) * 512 + h * 64 + c4) = *(const f32x4*)(YB + k * 64 + c4);
    }
  }
  __syncthreads();
#undef SCAN_TOK
#undef SCAN_LOAD
#undef SCAN_XFORM
}

constexpr int AT_K = 64 * 256, AT_V = 128 * 128, AT_STAGE = AT_K + AT_V;

DI void attn_item(const Params& p, int item, float lam, unsigned char* lds, int tid) {
  const int qb = item & 63, bh = item >> 6, h = bh & 3, b = bh >> 2;
  const int lane = tid & 63, wave = tid >> 6, fr = lane & 15, fg = lane >> 4;
  const bf16_t* QK = (const bf16_t*)(p.ws + O_QK);
  const bf16_t* VT = (const bf16_t*)(p.ws + O_VT);
  bf16_t* YC = (bf16_t*)(p.ws + O_YCAT);
  const int q0 = b * S + qb * 128 + wave * 16;
  bf16x8 qf[2][2];
#pragma unroll
  for (int c = 0; c < 2; ++c)
#pragma unroll
    for (int ks = 0; ks < 2; ++ks) qf[c][ks] = *(const bf16x8*)(QK + (size_t)(q0 + fr) * 1024 + h * 128 + c * 64 + ks * 32 + fg * 8);
  f32x4 o[2][8];
#pragma unroll
  for (int c = 0; c < 2; ++c)
#pragma unroll
    for (int i = 0; i < 8; ++i) o[c][i] = (f32x4){0.f, 0.f, 0.f, 0.f};
  float mrun[2] = {-1e30f, -1e30f}, lrun[2] = {0.f, 0.f};
  const int krow = tid >> 4, kkc = tid & 15;
  const int vrow = tid >> 3, vkc = tid & 7;
  const int kwo = krow * 256 + ((kkc ^ ((((krow & 31) >> 3) << 2) | (krow & 3))) * 16);
  const int vwo = AT_K + vrow * 128 + ((vkc ^ ((vrow >> 1) & 7)) * 16);
  const int krd = ((fr >> 2) * 8 + (fr & 3)) * 256;
  const int vrd = AT_K + fr * 128;
  const int frs = (fr >> 1) & 7;
  const bf16_t* gk = QK + (size_t)(b * S + krow) * 1024 + 512 + h * 128 + kkc * 8;
  const bf16_t* gv = VT + (size_t)((b * 4 + h) * 128 + vrow) * S + vkc * 8;
  u32x4 rk[2], rv[2];
#pragma unroll
  for (int i = 0; i < 2; ++i) {
    rk[i] = *(const u32x4*)(gk + (size_t)(32 * i) * 1024);
    rv[i] = *(const u32x4*)(gv + (size_t)(64 * i) * S);
  }
#pragma unroll
  for (int i = 0; i < 2; ++i) {
    *(u32x4*)(lds + kwo + i * 32 * 256) = rk[i];
    *(u32x4*)(lds + vwo + i * 64 * 128) = rv[i];
  }
  __syncthreads();
  for (int kt = 0; kt < 128; ++kt) {
    const bool more = (kt + 1 < 128);
    if (more) {
#pragma unroll
      for (int i = 0; i < 2; ++i) {
        rk[i] = *(const u32x4*)(gk + (size_t)((kt + 1) * 64 + 32 * i) * 1024);
        rv[i] = *(const u32x4*)(gv + (size_t)(64 * i) * S + (kt + 1) * 64);
      }
    }
    const unsigned char* sm = lds + (kt & 1) * AT_STAGE;
    bf16x8 pf[2][2];
#pragma unroll
    for (int c = 0; c < 2; ++c) {
      f32x4 s[4];
#pragma unroll
      for (int t4 = 0; t4 < 4; ++t4) {
        s[t4] = (f32x4){0.f, 0.f, 0.f, 0.f};
#pragma unroll
        for (int ks = 0; ks < 2; ++ks) {
          const bf16x8 kf = *(const bf16x8*)(sm + krd + ((t4 >> 1) * 32 + (t4 & 1) * 4) * 256 + (((c * 8 + ks * 4 + fg) ^ fr) * 16));
          s[t4] = __builtin_amdgcn_mfma_f32_16x16x32_bf16(kf, qf[c][ks], s[t4], 0, 0, 0);
        }
      }
      float mx = fmaxf(fmaxf(s[0][0], s[0][1]), fmaxf(s[0][2], s[0][3]));
#pragma unroll
      for (int t4 = 1; t4 < 4; ++t4) mx = fmaxf(mx, fmaxf(fmaxf(s[t4][0], s[t4][1]), fmaxf(s[t4][2], s[t4][3])));
      if (__any(mx > mrun[c] + 8.f)) {
        mx = fmaxf(mx, __shfl_xor(mx, 16));
        mx = fmaxf(mx, __shfl_xor(mx, 32));
        const float mn = fmaxf(mrun[c], mx);
        const float alpha = __builtin_amdgcn_exp2f(mrun[c] - mn);
        mrun[c] = mn;
        lrun[c] *= alpha;
#pragma unroll
        for (int i = 0; i < 8; ++i) o[c][i] = o[c][i] * alpha;
      }
      const float mr = mrun[c];
      float ps = 0.f;
#pragma unroll
      for (int t4 = 0; t4 < 4; ++t4)
#pragma unroll
        for (int j = 0; j < 4; ++j) {
          s[t4][j] = __builtin_amdgcn_exp2f(s[t4][j] - mr);
          ps += s[t4][j];
        }
      lrun[c] += ps;
#pragma unroll
      for (int kb = 0; kb < 2; ++kb) {
        u32x4 w;
        w.x = pk2(s[2 * kb][0], s[2 * kb][1]);
        w.y = pk2(s[2 * kb][2], s[2 * kb][3]);
        w.z = pk2(s[2 * kb + 1][0], s[2 * kb + 1][1]);
        w.w = pk2(s[2 * kb + 1][2], s[2 * kb + 1][3]);
        pf[c][kb] = __builtin_bit_cast(bf16x8, w);
      }
    }
#pragma unroll
    for (int vt = 0; vt < 8; ++vt)
#pragma unroll
      for (int kb = 0; kb < 2; ++kb) {
        const bf16x8 vf = *(const bf16x8*)(sm + vrd + vt * 16 * 128 + (((kb * 4 + fg) ^ frs) * 16));
        o[0][vt] = __builtin_amdgcn_mfma_f32_16x16x32_bf16(vf, pf[0][kb], o[0][vt], 0, 0, 0);
        o[1][vt] = __builtin_amdgcn_mfma_f32_16x16x32_bf16(vf, pf[1][kb], o[1][vt], 0, 0, 0);
      }
    if (more) {
      unsigned char* s2 = lds + ((kt + 1) & 1) * AT_STAGE;
#pragma unroll
      for (int i = 0; i < 2; ++i) {
        *(u32x4*)(s2 + kwo + i * 32 * 256) = rk[i];
        *(u32x4*)(s2 + vwo + i * 64 * 128) = rv[i];
      }
    }
    __syncthreads();
  }
  float l0 = lrun[0], l1 = lrun[1];
  l0 += __shfl_xor(l0, 16); l0 += __shfl_xor(l0, 32);
  l1 += __shfl_xor(l1, 16); l1 += __shfl_xor(l1, 32);
  const float i0 = 1.f / l0, i1 = lam / l1;
  float ss = 0.f;
#pragma unroll
  for (int vt = 0; vt < 8; ++vt) {
    o[0][vt] = o[0][vt] * i0 - o[1][vt] * i1;
#pragma unroll
    for (int j = 0; j < 4; ++j) ss += o[0][vt][j] * o[0][vt][j];
  }
  ss += __shfl_xor(ss, 16);
  ss += __shfl_xor(ss, 32);
  const float rs = rsqrtf(ss * (1.f / 128.f) + 1e-6f) * 0.8f;
#pragma unroll
  for (int vt = 0; vt < 8; ++vt) {
    const int vd = vt * 16 + fg * 4;
    const f32x4 g4 = *(const f32x4*)(p.subln + vd);
    st_bf4(YC + (size_t)(q0 + fr) * 1024 + h * 128 + vd, o[0][vt] * g4 * rs);
  }
}


#ifndef STOP
#define STOP 99
#endif
DI void digest(const Params& p, int which, int bid, int nb, int tid) {
  const unsigned char* ws = p.ws;
  for (size_t i = (size_t)bid * 512 + tid; i < (size_t)T * 1024; i += (size_t)nb * 512) {
    const size_t t = i >> 10; const int c = (int)(i & 1023);
    float v = 0.f;
    if (which == 3) {
      v = bf2f(((const bf16_t*)(ws + O_QK))[i]);
      if (c < 512) {
        const size_t o = t * 512 + c;
        v += bf2f(((const bf16_t*)(ws + O_VT))[o]) + bf2f(((const bf16_t*)(ws + O_RS))[o]) + bf2f(((const bf16_t*)(ws + O_KS))[o]) +
             bf2f(((const bf16_t*)(ws + O_VS))[o]) + bf2f(((const bf16_t*)(ws + O_KK))[o]) + bf2f(((const bf16_t*)(ws + O_E0))[o]) +
             bf2f(((const bf16_t*)(ws + O_E1))[o]) + bf2f(((const bf16_t*)(ws + O_A0))[o]) + bf2f(((const bf16_t*)(ws + O_A1))[o]) +
             bf2f(((const bf16_t*)(ws + O_GG))[o]);
      }
    } else if (which == 0) {
      v = bf2f(((const bf16_t*)(ws + O_XB))[i]) + ((const float*)(ws + O_RSTD1))[t] + bf2f(((const bf16_t*)(ws + O_WINT))[i % (size_t)(3456 * 1024)]) +
          bf2f(((const bf16_t*)(ws + O_WUPT))[i % (size_t)(5632 * 1024)]) + bf2f(((const bf16_t*)(ws + O_WDOWNT))[i % (size_t)(2816 * 1024)]) +
          bf2f(((const bf16_t*)(ws + O_WOUTT))[i % (size_t)(1024 * 1024)]) + bf2f(((const bf16_t*)(ws + O_W2T))[i % (size_t)(196608)]) +
          ((const float*)(ws + O_ROPE))[i % (size_t)(8192 * 64)];
    } else if (which == 1) {
      v = bf2f(((const bf16_t*)(ws + O_QK))[i]);
      if (c < 512) v += bf2f(((const bf16_t*)(ws + O_VT))[t * 512 + c]);
      v += bf2f(((const bf16_t*)(ws + O_Z))[t * 1920 + c]);
      if (c < 896) v += bf2f(((const bf16_t*)(ws + O_Z))[t * 1920 + 1024 + c]);
    } else if (which == 2) {
      if (c < 512) {
        const size_t o = t * 512 + c;
        v = bf2f(((const bf16_t*)(ws + O_RS))[o]) + bf2f(((const bf16_t*)(ws + O_KS))[o]) + bf2f(((const bf16_t*)(ws + O_VS))[o]) + bf2f(((const bf16_t*)(ws + O_KK))[o]);
      } else if (c < 896) v = bf2f(((const bf16_t*)(ws + O_LIN))[t * 384 + c - 512]);
    } else if (which == 6) {
      v = bf2f(((const bf16_t*)(ws + O_YCAT))[i]);
    }
    p.out[i] = v;
  }
}

__global__ void __launch_bounds__(512) mega(Params p) {
  cg::grid_group grid = cg::this_grid();
  extern __shared__ __attribute__((aligned(16))) unsigned char lds[];
  __shared__ int s_item;
  const int tid = threadIdx.x, bid = blockIdx.x, nb = gridDim.x, lane = tid & 63, wave = tid >> 6;
  const int gw = bid * 8 + wave, ngw = nb * 8;
  unsigned char* ws = p.ws;
  float* rstd1 = (float*)(ws + O_RSTD1);
  float* rstd2 = (float*)(ws + O_RSTD2);
  float* misc = (float*)(ws + O_MISC);

  {
    bf16_t* xb = (bf16_t*)(ws + O_XB);
    for (int row = gw; row < T; row += ngw) {
      const f32x4* xr = (const f32x4*)(p.x + (size_t)row * D) + lane;
      f32x4 v[4];
      float s = 0.f;
#pragma unroll
      for (int j = 0; j < 4; ++j) {
        v[j] = xr[64 * j];
        s += v[j][0] * v[j][0] + v[j][1] * v[j][1] + v[j][2] * v[j][2] + v[j][3] * v[j][3];
      }
      s = wave_sum(s);
      if (lane == 0) rstd1[row] = rsqrtf(s * (1.f / D) + 1e-6f);
      bf16_t* orow = xb + (size_t)row * D + lane * 4;
#pragma unroll
      for (int j = 0; j < 4; ++j) st_bf4(orow + 256 * j, v[j]);
    }
    float* tile = (float*)lds;
    transpose_job(p.w_in, D, NIN, (bf16_t*)(ws + O_WINT), p.pre_mix, true, tile, bid, nb, tid);
    transpose_job(p.w_out, D, D, (bf16_t*)(ws + O_WOUTT), nullptr, false, tile, bid, nb, tid);
    transpose_job(p.w_up, D, 2 * DFF, (bf16_t*)(ws + O_WUPT), p.pre_ffn, false, tile, bid, nb, tid);
    transpose_job(p.w_down, DFF, D, (bf16_t*)(ws + O_WDOWNT), nullptr, false, tile, bid, nb, tid);
    transpose_job(p.w2, 64, 512, (bf16_t*)(ws + O_W2T), nullptr, false, tile, bid, nb, tid);
    transpose_job(p.w2 + 64 * 512, 64, 512, (bf16_t*)(ws + O_W2T) + 512 * 64, nullptr, false, tile, bid, nb, tid);
    transpose_job(p.a2, 64, 512, (bf16_t*)(ws + O_A2T), nullptr, false, tile, bid, nb, tid);
    transpose_job(p.a2 + 64 * 512, 64, 512, (bf16_t*)(ws + O_A2T) + 512 * 64, nullptr, false, tile, bid, nb, tid);
    transpose_job(p.g2, 128, 512, (bf16_t*)(ws + O_G2T), nullptr, false, tile, bid, nb, tid);
    f32x2* rope = (f32x2*)(ws + O_ROPE);
    for (int i = bid * 512 + tid; i < S * 32; i += nb * 512) {
      const int s = i >> 5, f = i & 31;
      const float inv = powf(10000.f, -(float)f / 32.f);
      const float ang = (float)s * inv;
      rope[i] = (f32x2){cosf(ang), sinf(ang)};
    }
    if (bid == 0 && tid == 0) {
      float s1 = 0.f, s2 = 0.f;
      for (int i = 0; i < 64; ++i) {
        s1 += p.lq1[i] * p.lk1[i];
        s2 += p.lq2[i] * p.lk2[i];
      }
      misc[0] = expf(s1) - expf(s2) + 0.2f;
      ((int*)misc)[1] = 0;
    }
  }
  grid.sync();
  if (STOP == 0) { digest(p, 0, bid, nb, tid); return; }

  {
    const bf16_t* xb = (const bf16_t*)(ws + O_XB);
    const bf16_t* wt = (const bf16_t*)(ws + O_WINT);
    EpiInProj e1{rstd1, (const f32x2*)(ws + O_ROPE), (bf16_t*)(ws + O_QK), (bf16_t*)(ws + O_Z)};
    EpiV ev{rstd1, (bf16_t*)(ws + O_VT)};
    const int total = 256 * 27, per = (total + nb - 1) / nb, lo = bid * per, hi = min(total, lo + per);
    for (int it = lo; it < hi; ++it) {
      const int mt = it / 27, nt = it % 27;
      if (nt >= 8 && nt < 12) gemm_tile<true>(xb, D, wt, D, D, mt * 256, nt * 128, lds, ev, tid);
      else gemm_tile<false>(xb, D, wt, D, D, mt * 256, nt * 128, lds, e1, tid);
    }
  }
  grid.sync();
  if (STOP == 1) { digest(p, 1, bid, nb, tid); return; }

  {
    const bf16_t* Z = (const bf16_t*)(ws + O_Z);
    bf16_t* RS = (bf16_t*)(ws + O_RS);
    bf16_t* KS = (bf16_t*)(ws + O_KS);
    bf16_t* VS = (bf16_t*)(ws + O_VS);
    bf16_t* KK = (bf16_t*)(ws + O_KK);
    bf16_t* LIN = (bf16_t*)(ws + O_LIN);
    for (int t = gw; t < T; t += ngw) {
      const int s = t & (S - 1);
      const bool hp = s > 0, hn = s < S - 1;
      const bf16_t* zc = Z + (size_t)t * NRW;
#pragma unroll 3
      for (int it = 0; it < 15; ++it) {
        const int c = it * 128 + lane * 2;
        const u32 z0 = *(const u32*)(zc + c);
        const u32 zp = hp ? *(const u32*)(zc + c - NRW) : 0u;
        const u32 zn = hn ? *(const u32*)(zc + c + NRW) : 0u;
        const f32x2 m = *(const f32x2*)(p.mu + c);
        const float a0 = bflo(z0), a1 = bfhi(z0);
        const float v0 = a0 + (0.5f * (bflo(zp) + bflo(zn)) - a0) * m.x;
        const float v1 = a1 + (0.5f * (bfhi(zp) + bfhi(zn)) - a1) * m.y;
        if (it < 4) {
          *(u32*)(RS + (size_t)t * 512 + c) = pk2(v0, v1);
        } else if (it < 8) {
          const int cc = c - 512;
          *(u32*)(KS + (size_t)t * 512 + cc) = pk2(v0, v1);
          const f32x2 kk = *(const f32x2*)(p.k_k + cc);
          const float f0 = v0 * kk.x, f1 = v1 * kk.y;
          float ss = f0 * f0 + f1 * f1;
#pragma unroll
          for (int o = 1; o < 32; o <<= 1) ss += __shfl_xor(ss, o);
          const float rn = rsqrtf(fmaxf(ss, 1e-12f));
          *(u32*)(KK + (size_t)t * 512 + cc) = pk2(f0 * rn, f1 * rn);
        } else if (it < 12) {
          *(u32*)(VS + (size_t)t * 512 + (c - 1024)) = pk2(v0, v1);
        } else if (it == 12) {
          *(u32*)(LIN + (size_t)t * 384 + (c - 1536)) = pk2(tanhf(v0), tanhf(v1));
        } else if (it == 13) {
          *(u32*)(LIN + (size_t)t * 384 + (c - 1536)) = pk2(v0, v1);
        } else {
          *(u32*)(LIN + (size_t)t * 384 + (c - 1536)) = pk2(sigmoidf_(v0), sigmoidf_(v1));
        }
      }
    }
  }
  grid.sync();
  if (STOP == 2) { digest(p, 2, bid, nb, tid); return; }

  {
    const bf16_t* LIN = (const bf16_t*)(ws + O_LIN);
    const bf16_t* W2T = (const bf16_t*)(ws + O_W2T);
    const bf16_t* A2T = (const bf16_t*)(ws + O_A2T);
    const bf16_t* G2T = (const bf16_t*)(ws + O_G2T);
    for (int d = 0; d < 2; ++d) {
      EpiLora ee{0, p.w0 + d * 512, (bf16_t*)(ws + (d ? O_E1 : O_E0))};
      gemm_phase<false>(LIN + d * 64, 384, W2T + d * 512 * 64, 64, 64, 4, 0, 4, lds, ee, bid, nb, tid);
      EpiLora ea{1, p.a0 + d * 512, (bf16_t*)(ws + (d ? O_A1 : O_A0))};
      gemm_phase<false>(LIN + 128 + d * 64, 384, A2T + d * 512 * 64, 64, 64, 4, 0, 4, lds, ea, bid, nb, tid);
    }
    EpiLora eg{2, nullptr, (bf16_t*)(ws + O_GG)};
    gemm_phase<false>(LIN + 256, 384, G2T, 128, 128, 4, 0, 4, lds, eg, bid, nb, tid);
  }
  grid.sync();
  if (STOP == 3) { digest(p, 3, bid, nb, tid); return; }

  {
    const float lam = misc[0];
    int* counter = (int*)misc + 1;
    for (;;) {
      if (tid == 0) s_item = atomicAdd(counter, 1);
      __syncthreads();
      const int item = s_item;
      __syncthreads();
      if (item >= 128 + 2048) break;
      if (item < 128) scan_chain(p, item, lds, tid);
      else attn_item(p, item - 128, lam, lds, tid);
    }
  }
  grid.sync();

  {
    const float* Y0 = p.out;
    const float* Y1 = p.out + (size_t)T * 512;
    const bf16_t* RS = (const bf16_t*)(ws + O_RS);
    const bf16_t* KS = (const bf16_t*)(ws + O_KS);
    const bf16_t* VS = (const bf16_t*)(ws + O_VS);
    const bf16_t* A0 = (const bf16_t*)(ws + O_A0);
    const bf16_t* A1 = (const bf16_t*)(ws + O_A1);
    const bf16_t* GG = (const bf16_t*)(ws + O_GG);
    bf16_t* YC = (bf16_t*)(ws + O_YCAT);
    for (int idx = gw; idx < T * 8; idx += ngw) {
      const int t = idx >> 3, h = idx & 7, c = h * 64 + lane;
      const size_t o = (size_t)t * 512 + c;
      const float y = Y0[o] + Y1[o];
      const float mean = wave_sum(y) * (1.f / 64.f);
      const float dl = y - mean;
      const float var = wave_sum(dl * dl) * (1.f / 64.f);
      const float yn = dl * rsqrtf(var + 64e-5f) * p.gn_w[c] + p.gn_b[c];
      const float r = bf2f(RS[o]), k = bf2f(KS[o]), v = bf2f(VS[o]), a0 = bf2f(A0[o]), a1 = bf2f(A1[o]), g = bf2f(GG[o]);
      const float ka = p.k_a[c];
      const float kd = k * (2.f + (a0 + a1 - 2.f) * ka);
      const float bs = wave_sum(r * kd * p.r_k[c]);
      YC[(size_t)t * 1024 + 512 + c] = f2bf((yn + bs * v) * g);
    }
  }
  grid.sync();
  if (STOP == 6) { digest(p, 6, bid, nb, tid); return; }

  {
    EpiF32 e{(float*)(ws + O_MIX), D};
    gemm_phase<false>((const bf16_t*)(ws + O_YCAT), D, (const bf16_t*)(ws + O_WOUTT), D, D, 8, 0, 8, lds, e, bid, nb, tid);
  }
  grid.sync();

  {
    const float* mix = (const float*)(ws + O_MIX);
    bf16_t* x1b = (bf16_t*)(ws + O_X1B);
    for (int row = gw; row < T; row += ngw) {
      const f32x4* mr = (const f32x4*)(mix + (size_t)row * D) + lane;
      const f32x4* xr = (const f32x4*)(p.x + (size_t)row * D) + lane;
      const f32x4* gr = (const f32x4*)(p.post_mix) + lane;
      f32x4 mv[4];
      float s = 0.f;
#pragma unroll
      for (int j = 0; j < 4; ++j) {
        mv[j] = mr[64 * j];
        s += mv[j][0] * mv[j][0] + mv[j][1] * mv[j][1] + mv[j][2] * mv[j][2] + mv[j][3] * mv[j][3];
      }
      const float rs = rsqrtf(wave_sum(s) * (1.f / D) + 1e-6f);
      float s2 = 0.f;
      f32x4* orow = (f32x4*)(p.out + (size_t)row * D) + lane;
#pragma unroll
      for (int j = 0; j < 4; ++j) {
        mv[j] = xr[64 * j] + mv[j] * rs * gr[64 * j];
        s2 += mv[j][0] * mv[j][0] + mv[j][1] * mv[j][1] + mv[j][2] * mv[j][2] + mv[j][3] * mv[j][3];
        orow[64 * j] = mv[j];
        st_bf4(x1b + (size_t)row * D + lane * 4 + 256 * j, mv[j]);
      }
      s2 = wave_sum(s2);
      if (lane == 0) rstd2[row] = rsqrtf(s2 * (1.f / D) + 1e-6f);
    }
  }
  grid.sync();

  {
    EpiGate e{rstd2, (bf16_t*)(ws + O_G)};
    gemm_phase<false>((const bf16_t*)(ws + O_X1B), D, (const bf16_t*)(ws + O_WUPT), D, D, 22, 0, 22, lds, e, bid, nb, tid);
  }
  grid.sync();

  {
    EpiUp e{rstd2, (const bf16_t*)(ws + O_G), p.conv_w, p.conv_b, (bf16_t*)(ws + O_ACT)};
    gemm_phase<false>((const bf16_t*)(ws + O_X1B), D, (const bf16_t*)(ws + O_WUPT) + (size_t)DFF * D, D, D, 22, 0, 22, lds, e, bid, nb, tid);
  }
  grid.sync();

  {
    EpiF32 e{(float*)(ws + O_F), D};
    gemm_phase<false>((const bf16_t*)(ws + O_ACT), DFF, (const bf16_t*)(ws + O_WDOWNT), DFF, DFF, 8, 0, 8, lds, e, bid, nb, tid);
  }
  grid.sync();

  {
    const float* f = (const float*)(ws + O_F);
    for (int row = gw; row < T; row += ngw) {
      const f32x4* fr_ = (const f32x4*)(f + (size_t)row * D) + lane;
      const f32x4* gr = (const f32x4*)(p.post_ffn) + lane;
      f32x4* orow = (f32x4*)(p.out + (size_t)row * D) + lane;
      f32x4 fv[4];
      float s = 0.f;
#pragma unroll
      for (int j = 0; j < 4; ++j) {
        fv[j] = fr_[64 * j];
        s += fv[j][0] * fv[j][0] + fv[j][1] * fv[j][1] + fv[j][2] * fv[j][2] + fv[j][3] * fv[j][3];
      }
      const float rs = rsqrtf(wave_sum(s) * (1.f / D) + 1e-6f);
#pragma unroll
      for (int j = 0; j < 4; ++j) orow[64 * j] = orow[64 * j] + fv[j] * rs * gr[64 * j];
    }
  }
}

extern "C" void kernel_launch(void* const* d_in, const int* in_sizes, int n_in, void* d_out, int out_size, void* d_ws, size_t ws_size,
                              hipStream_t stream) {
  static int grid_blocks = 0;
  if (grid_blocks == 0) {
    if (n_in != 27 || in_sizes[0] != T * D || out_size != T * D || ws_size < WS_END) {
      fprintf(stderr, "kernel_launch: unexpected shapes (n_in %d, in0 %d, out %d, ws %zu)\n", n_in, n_in > 0 ? in_sizes[0] : -1, out_size, ws_size);
      grid_blocks = -1;
      return;
    }
    int dev = 0, cus = 0, per_cu = 0;
    (void)hipGetDevice(&dev);
    (void)hipDeviceGetAttribute(&cus, hipDeviceAttributeMultiprocessorCount, dev);
    (void)hipFuncSetAttribute((const void*)mega, hipFuncAttributeMaxDynamicSharedMemorySize, LDS_BYTES);
    (void)hipOccupancyMaxActiveBlocksPerMultiprocessor(&per_cu, (const void*)mega, 512, LDS_BYTES);
    if (per_cu < 1) per_cu = 1;
    grid_blocks = cus * per_cu;
  }
  if (grid_blocks < 0) return;
  Params p{};
  const float** pp = (const float**)&p;
  for (int i = 0; i < 27; ++i) pp[i] = (const float*)d_in[i];
  p.out = (float*)d_out;
  p.ws = (unsigned char*)d_ws;
  void* args[] = {&p};
  hipError_t e = hipLaunchCooperativeKernel((const void*)mega, dim3(grid_blocks), dim3(512), args, LDS_BYTES, stream);
  if (e != hipSuccess) fprintf(stderr, "cooperative launch failed: %s (grid %d)\n", hipGetErrorString(e), grid_blocks);
}
```

```cpp
#include <hip/hip_runtime.h>
#include <hip/hip_cooperative_groups.h>
#include <cstdio>
namespace cg = cooperative_groups;

typedef unsigned short bf16_t;
typedef short bf16x8 __attribute__((ext_vector_type(8)));
typedef float f32x4 __attribute__((ext_vector_type(4)));
typedef float f32x2 __attribute__((ext_vector_type(2)));
typedef unsigned int u32;
typedef u32 u32x4 __attribute__((ext_vector_type(4)));
typedef u32 u32x2 __attribute__((ext_vector_type(2)));

#define DI __device__ __forceinline__

constexpr int T = 65536, S = 8192, D = 1024, NIN = 3456, NRW = 1920, DFF = 2816;
constexpr size_t MiB = 1ull << 20;
constexpr size_t O_WINT = 0, O_WOUTT = 7 * MiB, O_WUPT = 9 * MiB, O_WDOWNT = 20 * MiB;
constexpr size_t O_W2T = 26 * MiB, O_A2T = O_W2T + 131072, O_G2T = O_W2T + 262144;
constexpr size_t O_ROPE = 27 * MiB, O_RSTD1 = 29 * MiB, O_RSTD2 = O_RSTD1 + 262144, O_MISC = 30 * MiB;
constexpr size_t O_XB = 32 * MiB, O_LIN = 32 * MiB, O_YCAT = 32 * MiB, O_ACT = 32 * MiB;
constexpr size_t O_QK = 160 * MiB, O_VT = 288 * MiB, O_MIX = 160 * MiB;
constexpr size_t O_Z = 352 * MiB, O_E0 = 352 * MiB, O_E1 = 416 * MiB, O_A0 = 480 * MiB, O_A1 = 544 * MiB, O_GG = 608 * MiB;
constexpr size_t O_RS = 672 * MiB, O_KS = 736 * MiB, O_VS = 800 * MiB, O_KK = 864 * MiB;
constexpr size_t O_X1B = 416 * MiB, O_G = 544 * MiB, O_F = 544 * MiB;
constexpr size_t WS_END = 928 * MiB;

constexpr int LDS_BYTES = 114688;
constexpr float QSCALE = 0.125f * 1.4426950408889634f;

struct Params {
  const float *x, *pre_mix, *post_mix, *pre_ffn, *post_ffn, *w_in, *lq1, *lk1, *lq2, *lk2, *subln, *mu, *w0, *w2, *a0, *a2, *g2,
      *k_k, *k_a, *r_k, *gn_w, *gn_b, *w_out, *w_up, *conv_w, *conv_b, *w_down;
  float* out;
  unsigned char* ws;
};

typedef __bf16 bf16x2_t __attribute__((ext_vector_type(2)));
DI u32 pk2(float lo, float hi) {
  f32x2 f = {lo, hi};
  bf16x2_t b = __builtin_convertvector(f, bf16x2_t);
  return __builtin_bit_cast(u32, b);
}
DI bf16_t f2bf(float f) { return (bf16_t)(pk2(f, 0.f) & 0xffffu); }
DI float bf2f(u32 h) { return __uint_as_float(h << 16); }
DI float bflo(u32 w) { return __uint_as_float(w << 16); }
DI float bfhi(u32 w) { return __uint_as_float(w & 0xffff0000u); }
DI void st_bf4(bf16_t* p, f32x4 v) {
  u32x2 o;
  o.x = pk2(v[0], v[1]);
  o.y = pk2(v[2], v[3]);
  *(u32x2*)p = o;
}
DI float wave_sum(float v) {
#pragma unroll
  for (int o = 1; o < 64; o <<= 1) v += __shfl_xor(v, o);
  return v;
}
DI float sigmoidf_(float u) { return 1.f / (1.f + __expf(-u)); }
template <int CTRL>
DI float dppf(float v) {
  return __builtin_bit_cast(float, __builtin_amdgcn_update_dpp(0, __builtin_bit_cast(int, v), CTRL, 0xF, 0xF, true));
}
DI float row_sum16(float v) {
  v += dppf<0x128>(v);
  v += dppf<0x124>(v);
  v += dppf<0x122>(v);
  v += dppf<0x121>(v);
  return v;
}


DI void gsync(unsigned* bar, unsigned target) {
  __threadfence();
  __syncthreads();
  if (threadIdx.x == 0) {
    __hip_atomic_fetch_add(bar, 1u, __ATOMIC_RELEASE, __HIP_MEMORY_SCOPE_AGENT);
    while (__hip_atomic_load(bar, __ATOMIC_RELAXED, __HIP_MEMORY_SCOPE_AGENT) < target) __builtin_amdgcn_s_sleep(2);
  }
  __syncthreads();
  __builtin_amdgcn_fence(__ATOMIC_ACQUIRE, "agent");
}

DI void transpose_job(const float* src, int K, int N, bf16_t* dst, const float* g, bool perm, float* tile, int bid, int nb, int tid) {
  const int nnt = N / 64, nit = (K / 64) * nnt;
  for (int it = bid; it < nit; it += nb) {
    const int kt = it / nnt, nt = it % nnt, k0 = kt * 64, n0 = nt * 64;
#pragma unroll
    for (int i = 0; i < 8; ++i) {
      const int kk = (tid >> 6) + 8 * i, nn = tid & 63;
      float v = src[(size_t)(k0 + kk) * N + n0 + nn];
      if (g) v *= g[k0 + kk];
      tile[kk * 65 + nn] = v;
    }
    __syncthreads();
#pragma unroll
    for (int i = 0; i < 8; ++i) {
      const int nn = (tid >> 6) + 8 * i, kk = tid & 63;
      const int n = n0 + nn;
      int nd = n;
      if (perm && n < 1024) {
        const int d = n & 63;
        nd = (n & ~63) | (2 * (d & 31) + (d >> 5));
      }
      dst[(size_t)nd * K + k0 + kk] = f2bf(tile[kk * 65 + nn]);
    }
    __syncthreads();
  }
}

constexpr int G_ASTAGE = 256 * 128, G_BSTAGE = 128 * 128, G_STAGE = G_ASTAGE + G_BSTAGE;

template <bool SWAP, class Epi>
DI void gemm_tile(const bf16_t* __restrict__ A, int lda, const bf16_t* __restrict__ Bt, int ldb, int K, int m0, int n0,
                  unsigned char* lds, const Epi& epi, int tid) {
  const int lane = tid & 63, wave = tid >> 6, wm = wave >> 1, wn = wave & 1, fr = lane & 15, fg = lane >> 4;
  f32x4 acc[4][4];
#pragma unroll
  for (int i = 0; i < 4; ++i)
#pragma unroll
    for (int j = 0; j < 4; ++j) acc[i][j] = (f32x4){0.f, 0.f, 0.f, 0.f};
  const int nk = K / 64;
  const int srow = tid >> 3, skc = tid & 7;
  const int swo = ((skc ^ ((srow >> 1) & 7)) * 16);
  const int frs = (fr >> 1) & 7;
  const bf16_t* ga = A + (size_t)(m0 + srow) * lda + skc * 8;
  const bf16_t* gb = Bt + (size_t)(n0 + srow) * ldb + skc * 8;
  u32x4 ra[4], rb[2];
#pragma unroll
  for (int i = 0; i < 4; ++i) ra[i] = *(const u32x4*)(ga + (size_t)(64 * i) * lda);
#pragma unroll
  for (int i = 0; i < 2; ++i) rb[i] = *(const u32x4*)(gb + (size_t)(64 * i) * ldb);
  {
    unsigned char* as = lds;
    unsigned char* bs = lds + G_ASTAGE;
#pragma unroll
    for (int i = 0; i < 4; ++i) *(u32x4*)(as + (srow + 64 * i) * 128 + swo) = ra[i];
#pragma unroll
    for (int i = 0; i < 2; ++i) *(u32x4*)(bs + (srow + 64 * i) * 128 + swo) = rb[i];
  }
  __syncthreads();
  for (int kt = 0; kt < nk; ++kt) {
    const bool more = (kt + 1 < nk);
    if (more) {
#pragma unroll
      for (int i = 0; i < 4; ++i) ra[i] = *(const u32x4*)(ga + (size_t)(64 * i) * lda + (kt + 1) * 64);
#pragma unroll
      for (int i = 0; i < 2; ++i) rb[i] = *(const u32x4*)(gb + (size_t)(64 * i) * ldb + (kt + 1) * 64);
    }
    const unsigned char* as = lds + (kt & 1) * G_STAGE;
    const unsigned char* bs = as + G_ASTAGE;
#pragma unroll
    for (int ks = 0; ks < 2; ++ks) {
      bf16x8 af[4], bfr[4];
#pragma unroll
      for (int i = 0; i < 4; ++i) af[i] = *(const bf16x8*)(as + (wm * 64 + i * 16 + fr) * 128 + (((ks * 4 + fg) ^ frs) * 16));
#pragma unroll
      for (int i = 0; i < 4; ++i) bfr[i] = *(const bf16x8*)(bs + (wn * 64 + i * 16 + fr) * 128 + (((ks * 4 + fg) ^ frs) * 16));
#pragma unroll
      for (int mi = 0; mi < 4; ++mi)
#pragma unroll
        for (int ni = 0; ni < 4; ++ni) {
          if (SWAP) acc[mi][ni] = __builtin_amdgcn_mfma_f32_16x16x32_bf16(af[mi], bfr[ni], acc[mi][ni], 0, 0, 0);
          else acc[mi][ni] = __builtin_amdgcn_mfma_f32_16x16x32_bf16(bfr[ni], af[mi], acc[mi][ni], 0, 0, 0);
        }
    }
    if (more) {
      unsigned char* as2 = lds + ((kt + 1) & 1) * G_STAGE;
      unsigned char* bs2 = as2 + G_ASTAGE;
#pragma unroll
      for (int i = 0; i < 4; ++i) *(u32x4*)(as2 + (srow + 64 * i) * 128 + swo) = ra[i];
#pragma unroll
      for (int i = 0; i < 2; ++i) *(u32x4*)(bs2 + (srow + 64 * i) * 128 + swo) = rb[i];
    }
    __syncthreads();
  }
#pragma unroll
  for (int mi = 0; mi < 4; ++mi)
#pragma unroll
    for (int ni = 0; ni < 4; ++ni) {
      if (SWAP) epi(m0 + wm * 64 + mi * 16 + fg * 4, n0 + wn * 64 + ni * 16 + fr, acc[mi][ni]);
      else epi(m0 + wm * 64 + mi * 16 + fr, n0 + wn * 64 + ni * 16 + fg * 4, acc[mi][ni]);
    }
}

struct EpiInProj {
  const float* rstd; const f32x2* rope; bf16_t* qk; bf16_t* z;
  DI void operator()(int m, int n, f32x4 v) const {
    const float rs = rstd[m];
    v = v * rs;
    if (n < 1024) {
      const int s = m & (S - 1), i = (n & 63) >> 1;
      const f32x2 c0 = rope[s * 32 + i], c1 = rope[s * 32 + i + 1];
      float a = v[0], b = v[1];
      v[0] = a * c0.x - b * c0.y; v[1] = b * c0.x + a * c0.y;
      a = v[2]; b = v[3];
      v[2] = a * c1.x - b * c1.y; v[3] = b * c1.x + a * c1.y;
      if (n < 512) v = v * QSCALE;
      st_bf4(qk + (size_t)m * 1024 + n, v);
    } else {
      st_bf4(z + (size_t)m * NRW + (n - 1536), v);
    }
  }
};
struct EpiV {
  const float* rstd; bf16_t* vt;
  DI void operator()(int m, int n, f32x4 v) const {
    const f32x4 rs = *(const f32x4*)(rstd + m);
    v = v * rs;
    const int nn = n - 1024, h = nn >> 7, vd = nn & 127, b = m >> 13, s = m & (S - 1);
    st_bf4(vt + ((size_t)((b * 4 + h) * 128 + vd)) * S + s, v);
  }
};
struct EpiLora {
  int mode; const float* bias; bf16_t* out;
  DI void operator()(int m, int n, f32x4 v) const {
    if (mode < 2) {
      const f32x4 bv = *(const f32x4*)(bias + n);
      const float sc = mode == 0 ? 0.60653065971f : 1.f;
#pragma unroll
      for (int j = 0; j < 4; ++j) v[j] = sc * sigmoidf_(v[j] + bv[j]);
    }
    st_bf4(out + (size_t)m * 512 + n, v);
  }
};
struct EpiF32 {
  float* out; int ld;
  DI void operator()(int m, int n, f32x4 v) const { *(f32x4*)(out + (size_t)m * ld + n) = v; }
};
struct EpiGate {
  const float* rstd; bf16_t* g;
  DI void operator()(int m, int n, f32x4 v) const { st_bf4(g + (size_t)m * DFF + n, v * rstd[m]); }
};
struct EpiUp {
  const float* rstd; const bf16_t* g; const float* cw; const float* cb; bf16_t* act;
  DI void operator()(int m, int n, f32x4 v) const {
    v = v * rstd[m];
    const int s = m & (S - 1);
    const bf16_t* gp = g + (size_t)m * DFF + n;
    const u32x2 g0 = *(const u32x2*)gp;
    u32x2 gm = (u32x2){0u, 0u}, gn = (u32x2){0u, 0u};
    if (s > 0) gm = *(const u32x2*)(gp - DFF);
    if (s < S - 1) gn = *(const u32x2*)(gp + DFF);
    const f32x4 w0 = *(const f32x4*)(cw + n), w1 = *(const f32x4*)(cw + DFF + n), w2 = *(const f32x4*)(cw + 2 * DFF + n), bb = *(const f32x4*)(cb + n);
    f32x4 c, p, q;
    c[0] = bflo(g0.x); c[1] = bfhi(g0.x); c[2] = bflo(g0.y); c[3] = bfhi(g0.y);
    p[0] = bflo(gm.x); p[1] = bfhi(gm.x); p[2] = bflo(gm.y); p[3] = bfhi(gm.y);
    q[0] = bflo(gn.x); q[1] = bfhi(gn.x); q[2] = bflo(gn.y); q[3] = bfhi(gn.y);
    f32x4 o;
#pragma unroll
    for (int j = 0; j < 4; ++j) {
      const float xg = w0[j] * p[j] + w1[j] * c[j] + w2[j] * q[j] + bb[j];
      const float y = 0.7978845608028654f * (xg + 0.044715f * xg * xg * xg);
      o[j] = xg / (1.f + __expf(-2.f * y)) * v[j];
    }
    st_bf4(act + (size_t)m * DFF + n, o);
  }
};

DI bool tile_of(int r, int bid, int nb, int w, int& mt, int& n) {
  if (nb == 256) {
    if (r >= w) return false;
    const int grp = bid & 7, j = bid >> 3, L = r * 32 + j, g = L / (w * 8), rem = L - g * w * 8;
    n = rem >> 3;
    mt = grp * 32 + g * 8 + (rem & 7);
    return true;
  }
  const int total = 256 * w, per = (total + nb - 1) / nb, it = bid * per + r;
  if (r >= per || it >= total) return false;
  mt = it / w;
  n = it % w;
  return true;
}
template <bool SWAP, class Epi>
DI void gemm_phase(const bf16_t* A, int lda, const bf16_t* Bt, int ldb, int K, int ntn, int nt_lo, int nt_hi, unsigned char* lds, const Epi& epi,
                   int bid, int nb, int tid) {
  const int w = nt_hi - nt_lo;
  for (int r = 0;; ++r) {
    int mt, n;
    if (!tile_of(r, bid, nb, w, mt, n)) break;
    gemm_tile<SWAP>(A, lda, Bt, ldb, K, mt * 256, (nt_lo + n) * 128, lds, epi, tid);
  }
}

DI void scan_chain(const Params& p, int chain, unsigned char* lds, int tid) {
  const int d = chain & 1, h = (chain >> 1) & 7, b = chain >> 4;
  float* rec = (float*)lds;
  float* ybuf = (float*)(lds + 98304);
  const bf16_t* RS = (const bf16_t*)(p.ws + O_RS);
  const bf16_t* KS = (const bf16_t*)(p.ws + O_KS);
  const bf16_t* VS = (const bf16_t*)(p.ws + O_VS);
  const bf16_t* KK = (const bf16_t*)(p.ws + O_KK);
  const bf16_t* EE = (const bf16_t*)(p.ws + (d ? O_E1 : O_E0));
  const bf16_t* AA = (const bf16_t*)(p.ws + (d ? O_A1 : O_A0));
  float* Y = p.out + (size_t)d * T * 512;
  const int lane = tid & 63, wave = tid >> 6, cgi = lane & 15, rg = lane >> 4, row0 = wave * 8 + rg * 2;
  const float ka = p.k_a[h * 64 + lane];
  float S0[4] = {0.f, 0.f, 0.f, 0.f}, S1[4] = {0.f, 0.f, 0.f, 0.f};
  bf16_t pr[4][6];
  const int ch = h * 64 + lane;
#define SCAN_TOK(n, k) ((size_t)(b * S + (d ? (S - 1 - ((n) * 32 + (k))) : ((n) * 32 + (k)))))
#define SCAN_LOAD(n)                                                      \
  _Pragma("unroll") for (int i = 0; i < 4; ++i) {                         \
    const size_t o_ = SCAN_TOK(n, wave + 8 * i) * 512 + ch;               \
    pr[i][0] = RS[o_]; pr[i][1] = KS[o_]; pr[i][2] = VS[o_];              \
    pr[i][3] = KK[o_]; pr[i][4] = EE[o_]; pr[i][5] = AA[o_];              \
  }
#define SCAN_XFORM(buf)                                                   \
  _Pragma("unroll") for (int i = 0; i < 4; ++i) {                         \
    float* R_ = rec + (buf) * 12288 + (wave + 8 * i) * 384 + lane;        \
    const float r_ = bf2f(pr[i][0]), k_ = bf2f(pr[i][1]), v_ = bf2f(pr[i][2]), kk_ = bf2f(pr[i][3]), e_ = bf2f(pr[i][4]), a_ = bf2f(pr[i][5]); \
    R_[0] = __expf(-e_); R_[64] = kk_; R_[128] = kk_ * a_; R_[192] = k_ * (1.f + (a_ - 1.f) * ka); R_[256] = r_; R_[320] = v_; \
  }
  SCAN_LOAD(0);
  SCAN_XFORM(0);
  __syncthreads();
  for (int n = 0; n < 256; ++n) {
    if (n + 1 < 256) { SCAN_LOAD(n + 1); }
    const float* RB = rec + (n & 1) * 12288;
    float* YB = ybuf + (n & 1) * 2048;
#pragma unroll 4
    for (int k = 0; k < 32; ++k) {
      const float* R = RB + k * 384;
      const f32x4 w4 = *(const f32x4*)(R + cgi * 4), kk4 = *(const f32x4*)(R + 64 + cgi * 4), b4 = *(const f32x4*)(R + 128 + cgi * 4),
                  kd4 = *(const f32x4*)(R + 192 + cgi * 4), r4 = *(const f32x4*)(R + 256 + cgi * 4);
      const f32x2 v2 = *(const f32x2*)(R + 320 + row0);
      float d0 = S0[0] * kk4[0] + S0[1] * kk4[1] + S0[2] * kk4[2] + S0[3] * kk4[3];
      float d1 = S1[0] * kk4[0] + S1[1] * kk4[1] + S1[2] * kk4[2] + S1[3] * kk4[3];
      d0 = row_sum16(d0);
      d1 = row_sum16(d1);
      float y0 = 0.f, y1 = 0.f;
#pragma unroll
      for (int c = 0; c < 4; ++c) {
        S0[c] = S0[c] * w4[c] + (v2.x * kd4[c] - d0 * b4[c]);
        S1[c] = S1[c] * w4[c] + (v2.y * kd4[c] - d1 * b4[c]);
        y0 += S0[c] * r4[c];
        y1 += S1[c] * r4[c];
      }
      y0 = row_sum16(y0);
      y1 = row_sum16(y1);
      if (cgi == 0) *(f32x2*)(YB + k * 64 + row0) = (f32x2){y0, y1};
    }
    if (n + 1 < 256) { SCAN_XFORM((n + 1) & 1); }
    __syncthreads();
    {
      const int k = tid >> 4, c4 = (tid & 15) * 4;
      *(f32x4*)(Y + SCAN_TOK(n, k) * 512 + h * 64 + c4) = *(const f32x4*)(YB + k * 64 + c4);
    }
  }
  __syncthreads();
#undef SCAN_TOK
#undef SCAN_LOAD
#undef SCAN_XFORM
}

constexpr int AT_K = 64 * 256, AT_V = 128 * 128, AT_STAGE = AT_K + AT_V;

DI void attn_item(const Params& p, int item, float lam, unsigned char* lds, int tid) {
  const int qb = item & 63, bh = item >> 6, h = bh & 3, b = bh >> 2;
  const int lane = tid & 63, wave = tid >> 6, fr = lane & 15, fg = lane >> 4;
  const bf16_t* QK = (const bf16_t*)(p.ws + O_QK);
  const bf16_t* VT = (const bf16_t*)(p.ws + O_VT);
  bf16_t* YC = (bf16_t*)(p.ws + O_YCAT);
  const int q0 = b * S + qb * 128 + wave * 16;
  bf16x8 qf[2][2];
#pragma unroll
  for (int c = 0; c < 2; ++c)
#pragma unroll
    for (int ks = 0; ks < 2; ++ks) qf[c][ks] = *(const bf16x8*)(QK + (size_t)(q0 + fr) * 1024 + h * 128 + c * 64 + ks * 32 + fg * 8);
  f32x4 o[2][8];
#pragma unroll
  for (int c = 0; c < 2; ++c)
#pragma unroll
    for (int i = 0; i < 8; ++i) o[c][i] = (f32x4){0.f, 0.f, 0.f, 0.f};
  float mrun[2] = {-1e30f, -1e30f}, lrun[2] = {0.f, 0.f};
  const int krow = tid >> 4, kkc = tid & 15;
  const int vrow = tid >> 3, vkc = tid & 7;
  const int kwo = krow * 256 + ((kkc ^ ((((krow & 31) >> 3) << 2) | (krow & 3))) * 16);
  const int vwo = AT_K + vrow * 128 + ((vkc ^ ((vrow >> 1) & 7)) * 16);
  const int krd = ((fr >> 2) * 8 + (fr & 3)) * 256;
  const int vrd = AT_K + fr * 128;
  const int frs = (fr >> 1) & 7;
  const bf16_t* gk = QK + (size_t)(b * S + krow) * 1024 + 512 + h * 128 + kkc * 8;
  const bf16_t* gv = VT + (size_t)((b * 4 + h) * 128 + vrow) * S + vkc * 8;
  u32x4 rk[2], rv[2];
#pragma unroll
  for (int i = 0; i < 2; ++i) {
    rk[i] = *(const u32x4*)(gk + (size_t)(32 * i) * 1024);
    rv[i] = *(const u32x4*)(gv + (size_t)(64 * i) * S);
  }
#pragma unroll
  for (int i = 0; i < 2; ++i) {
    *(u32x4*)(lds + kwo + i * 32 * 256) = rk[i];
    *(u32x4*)(lds + vwo + i * 64 * 128) = rv[i];
  }
  __syncthreads();
  for (int kt = 0; kt < 128; ++kt) {
    const bool more = (kt + 1 < 128);
    if (more) {
#pragma unroll
      for (int i = 0; i < 2; ++i) {
        rk[i] = *(const u32x4*)(gk + (size_t)((kt + 1) * 64 + 32 * i) * 1024);
        rv[i] = *(const u32x4*)(gv + (size_t)(64 * i) * S + (kt + 1) * 64);
      }
    }
    const unsigned char* sm = lds + (kt & 1) * AT_STAGE;
    bf16x8 pf[2][2];
#pragma unroll
    for (int c = 0; c < 2; ++c) {
      f32x4 s[4];
#pragma unroll
      for (int t4 = 0; t4 < 4; ++t4) {
        s[t4] = (f32x4){0.f, 0.f, 0.f, 0.f};
#pragma unroll
        for (int ks = 0; ks < 2; ++ks) {
          const bf16x8 kf = *(const bf16x8*)(sm + krd + ((t4 >> 1) * 32 + (t4 & 1) * 4) * 256 + (((c * 8 + ks * 4 + fg) ^ fr) * 16));
          s[t4] = __builtin_amdgcn_mfma_f32_16x16x32_bf16(kf, qf[c][ks], s[t4], 0, 0, 0);
        }
      }
      float mx = fmaxf(fmaxf(s[0][0], s[0][1]), fmaxf(s[0][2], s[0][3]));
#pragma unroll
      for (int t4 = 1; t4 < 4; ++t4) mx = fmaxf(mx, fmaxf(fmaxf(s[t4][0], s[t4][1]), fmaxf(s[t4][2], s[t4][3])));
      if (__any(mx > mrun[c] + 8.f)) {
        mx = fmaxf(mx, __shfl_xor(mx, 16));
        mx = fmaxf(mx, __shfl_xor(mx, 32));
        const float mn = fmaxf(mrun[c], mx);
        const float alpha = __builtin_amdgcn_exp2f(mrun[c] - mn);
        mrun[c] = mn;
        lrun[c] *= alpha;
#pragma unroll
        for (int i = 0; i < 8; ++i) o[c][i] = o[c][i] * alpha;
      }
      const float mr = mrun[c];
      float ps = 0.f;
#pragma unroll
      for (int t4 = 0; t4 < 4; ++t4)
#pragma unroll
        for (int j = 0; j < 4; ++j) {
          s[t4][j] = __builtin_amdgcn_exp2f(s[t4][j] - mr);
          ps += s[t4][j];
        }
      lrun[c] += ps;
#pragma unroll
      for (int kb = 0; kb < 2; ++kb) {
        u32x4 w;
        w.x = pk2(s[2 * kb][0], s[2 * kb][1]);
        w.y = pk2(s[2 * kb][2], s[2 * kb][3]);
        w.z = pk2(s[2 * kb + 1][0], s[2 * kb + 1][1]);
        w.w = pk2(s[2 * kb + 1][2], s[2 * kb + 1][3]);
        pf[c][kb] = __builtin_bit_cast(bf16x8, w);
      }
    }
#pragma unroll
    for (int vt = 0; vt < 8; ++vt)
#pragma unroll
      for (int kb = 0; kb < 2; ++kb) {
        const bf16x8 vf = *(const bf16x8*)(sm + vrd + vt * 16 * 128 + (((kb * 4 + fg) ^ frs) * 16));
        o[0][vt] = __builtin_amdgcn_mfma_f32_16x16x32_bf16(vf, pf[0][kb], o[0][vt], 0, 0, 0);
        o[1][vt] = __builtin_amdgcn_mfma_f32_16x16x32_bf16(vf, pf[1][kb], o[1][vt], 0, 0, 0);
      }
    if (more) {
      unsigned char* s2 = lds + ((kt + 1) & 1) * AT_STAGE;
#pragma unroll
      for (int i = 0; i < 2; ++i) {
        *(u32x4*)(s2 + kwo + i * 32 * 256) = rk[i];
        *(u32x4*)(s2 + vwo + i * 64 * 128) = rv[i];
      }
    }
    __syncthreads();
  }
  float l0 = lrun[0], l1 = lrun[1];
  l0 += __shfl_xor(l0, 16); l0 += __shfl_xor(l0, 32);
  l1 += __shfl_xor(l1, 16); l1 += __shfl_xor(l1, 32);
  const float i0 = 1.f / l0, i1 = lam / l1;
  float ss = 0.f;
#pragma unroll
  for (int vt = 0; vt < 8; ++vt) {
    o[0][vt] = o[0][vt] * i0 - o[1][vt] * i1;
#pragma unroll
    for (int j = 0; j < 4; ++j) ss += o[0][vt][j] * o[0][vt][j];
  }
  ss += __shfl_xor(ss, 16);
  ss += __shfl_xor(ss, 32);
  const float rs = rsqrtf(ss * (1.f / 128.f) + 1e-6f) * 0.8f;
#pragma unroll
  for (int vt = 0; vt < 8; ++vt) {
    const int vd = vt * 16 + fg * 4;
    const f32x4 g4 = *(const f32x4*)(p.subln + vd);
    st_bf4(YC + (size_t)(q0 + fr) * 1024 + h * 128 + vd, o[0][vt] * g4 * rs);
  }
}


#ifndef STOP
#define STOP 99
#endif
DI void digest(const Params& p, int which, int bid, int nb, int tid) {
  const unsigned char* ws = p.ws;
  for (size_t i = (size_t)bid * 512 + tid; i < (size_t)T * 1024; i += (size_t)nb * 512) {
    const size_t t = i >> 10; const int c = (int)(i & 1023);
    float v = 0.f;
    if (which == 3) {
      v = bf2f(((const bf16_t*)(ws + O_QK))[i]);
      if (c < 512) {
        const size_t o = t * 512 + c;
        v += bf2f(((const bf16_t*)(ws + O_VT))[o]) + bf2f(((const bf16_t*)(ws + O_RS))[o]) + bf2f(((const bf16_t*)(ws + O_KS))[o]) +
             bf2f(((const bf16_t*)(ws + O_VS))[o]) + bf2f(((const bf16_t*)(ws + O_KK))[o]) + bf2f(((const bf16_t*)(ws + O_E0))[o]) +
             bf2f(((const bf16_t*)(ws + O_E1))[o]) + bf2f(((const bf16_t*)(ws + O_A0))[o]) + bf2f(((const bf16_t*)(ws + O_A1))[o]) +
             bf2f(((const bf16_t*)(ws + O_GG))[o]);
      }
    } else if (which == 0) {
      v = bf2f(((const bf16_t*)(ws + O_XB))[i]) + ((const float*)(ws + O_RSTD1))[t] + bf2f(((const bf16_t*)(ws + O_WINT))[i % (size_t)(3456 * 1024)]) +
          bf2f(((const bf16_t*)(ws + O_WUPT))[i % (size_t)(5632 * 1024)]) + bf2f(((const bf16_t*)(ws + O_WDOWNT))[i % (size_t)(2816 * 1024)]) +
          bf2f(((const bf16_t*)(ws + O_WOUTT))[i % (size_t)(1024 * 1024)]) + bf2f(((const bf16_t*)(ws + O_W2T))[i % (size_t)(196608)]) +
          ((const float*)(ws + O_ROPE))[i % (size_t)(8192 * 64)];
    } else if (which == 1) {
      v = bf2f(((const bf16_t*)(ws + O_QK))[i]);
      if (c < 512) v += bf2f(((const bf16_t*)(ws + O_VT))[t * 512 + c]);
      v += bf2f(((const bf16_t*)(ws + O_Z))[t * 1920 + c]);
      if (c < 896) v += bf2f(((const bf16_t*)(ws + O_Z))[t * 1920 + 1024 + c]);
    } else if (which == 2) {
      if (c < 512) {
        const size_t o = t * 512 + c;
        v = bf2f(((const bf16_t*)(ws + O_RS))[o]) + bf2f(((const bf16_t*)(ws + O_KS))[o]) + bf2f(((const bf16_t*)(ws + O_VS))[o]) + bf2f(((const bf16_t*)(ws + O_KK))[o]);
      } else if (c < 896) v = bf2f(((const bf16_t*)(ws + O_LIN))[t * 384 + c - 512]);
    } else if (which == 6) {
      v = bf2f(((const bf16_t*)(ws + O_YCAT))[i]);
    }
    p.out[i] = v;
  }
}

__global__ void __launch_bounds__(512) mega(Params p) {
  cg::grid_group grid = cg::this_grid();
  extern __shared__ __attribute__((aligned(16))) unsigned char lds[];
  __shared__ int s_item;
  const int tid = threadIdx.x, bid = blockIdx.x, nb = gridDim.x, lane = tid & 63, wave = tid >> 6;
  const int gw = bid * 8 + wave, ngw = nb * 8;
  unsigned char* ws = p.ws;
  float* rstd1 = (float*)(ws + O_RSTD1);
  float* rstd2 = (float*)(ws + O_RSTD2);
  float* misc = (float*)(ws + O_MISC);

  {
    bf16_t* xb = (bf16_t*)(ws + O_XB);
    for (int row = gw; row < T; row += ngw) {
      const f32x4* xr = (const f32x4*)(p.x + (size_t)row * D) + lane;
      f32x4 v[4];
      float s = 0.f;
#pragma unroll
      for (int j = 0; j < 4; ++j) {
        v[j] = xr[64 * j];
        s += v[j][0] * v[j][0] + v[j][1] * v[j][1] + v[j][2] * v[j][2] + v[j][3] * v[j][3];
      }
      s = wave_sum(s);
      if (lane == 0) rstd1[row] = rsqrtf(s * (1.f / D) + 1e-6f);
      bf16_t* orow = xb + (size_t)row * D + lane * 4;
#pragma unroll
      for (int j = 0; j < 4; ++j) st_bf4(orow + 256 * j, v[j]);
    }
    float* tile = (float*)lds;
    transpose_job(p.w_in, D, NIN, (bf16_t*)(ws + O_WINT), p.pre_mix, true, tile, bid, nb, tid);
    transpose_job(p.w_out, D, D, (bf16_t*)(ws + O_WOUTT), nullptr, false, tile, bid, nb, tid);
    transpose_job(p.w_up, D, 2 * DFF, (bf16_t*)(ws + O_WUPT), p.pre_ffn, false, tile, bid, nb, tid);
    transpose_job(p.w_down, DFF, D, (bf16_t*)(ws + O_WDOWNT), nullptr, false, tile, bid, nb, tid);
    transpose_job(p.w2, 64, 512, (bf16_t*)(ws + O_W2T), nullptr, false, tile, bid, nb, tid);
    transpose_job(p.w2 + 64 * 512, 64, 512, (bf16_t*)(ws + O_W2T) + 512 * 64, nullptr, false, tile, bid, nb, tid);
    transpose_job(p.a2, 64, 512, (bf16_t*)(ws + O_A2T), nullptr, false, tile, bid, nb, tid);
    transpose_job(p.a2 + 64 * 512, 64, 512, (bf16_t*)(ws + O_A2T) + 512 * 64, nullptr, false, tile, bid, nb, tid);
    transpose_job(p.g2, 128, 512, (bf16_t*)(ws + O_G2T), nullptr, false, tile, bid, nb, tid);
    f32x2* rope = (f32x2*)(ws + O_ROPE);
    for (int i = bid * 512 + tid; i < S * 32; i += nb * 512) {
      const int s = i >> 5, f = i & 31;
      const float inv = powf(10000.f, -(float)f / 32.f);
      const float ang = (float)s * inv;
      rope[i] = (f32x2){cosf(ang), sinf(ang)};
    }
    if (bid == 0 && tid == 0) {
      float s1 = 0.f, s2 = 0.f;
      for (int i = 0; i < 64; ++i) {
        s1 += p.lq1[i] * p.lk1[i];
        s2 += p.lq2[i] * p.lk2[i];
      }
      misc[0] = expf(s1) - expf(s2) + 0.2f;
      for (int i = 0; i < 8; ++i) ((int*)misc)[16 + i * 16] = 0;
    }
  }
  grid.sync();
  if (STOP == 0) { digest(p, 0, bid, nb, tid); return; }

  {
    const bf16_t* xb = (const bf16_t*)(ws + O_XB);
    const bf16_t* wt = (const bf16_t*)(ws + O_WINT);
    EpiInProj e1{rstd1, (const f32x2*)(ws + O_ROPE), (bf16_t*)(ws + O_QK), (bf16_t*)(ws + O_Z)};
    EpiV ev{rstd1, (bf16_t*)(ws + O_VT)};
    for (int r = 0;; ++r) {
      int mt, nt;
      if (!tile_of(r, bid, nb, 27, mt, nt)) break;
      if (nt >= 8 && nt < 12) gemm_tile<true>(xb, D, wt, D, D, mt * 256, nt * 128, lds, ev, tid);
      else gemm_tile<false>(xb, D, wt, D, D, mt * 256, nt * 128, lds, e1, tid);
    }
  }
  grid.sync();

  {
    const bf16_t* Z = (const bf16_t*)(ws + O_Z);
    bf16_t* RS = (bf16_t*)(ws + O_RS);
    bf16_t* KS = (bf16_t*)(ws + O_KS);
    bf16_t* VS = (bf16_t*)(ws + O_VS);
    bf16_t* KK = (bf16_t*)(ws + O_KK);
    bf16_t* LIN = (bf16_t*)(ws + O_LIN);
    for (int t = gw; t < T; t += ngw) {
      const int s = t & (S - 1);
      const bool hp = s > 0, hn = s < S - 1;
      const bf16_t* zc = Z + (size_t)t * NRW;
#pragma unroll 3
      for (int it = 0; it < 15; ++it) {
        const int c = it * 128 + lane * 2;
        const u32 z0 = *(const u32*)(zc + c);
        const u32 zp = hp ? *(const u32*)(zc + c - NRW) : 0u;
        const u32 zn = hn ? *(const u32*)(zc + c + NRW) : 0u;
        const f32x2 m = *(const f32x2*)(p.mu + c);
        const float a0 = bflo(z0), a1 = bfhi(z0);
        const float v0 = a0 + (0.5f * (bflo(zp) + bflo(zn)) - a0) * m.x;
        const float v1 = a1 + (0.5f * (bfhi(zp) + bfhi(zn)) - a1) * m.y;
        if (it < 4) {
          *(u32*)(RS + (size_t)t * 512 + c) = pk2(v0, v1);
        } else if (it < 8) {
          const int cc = c - 512;
          *(u32*)(KS + (size_t)t * 512 + cc) = pk2(v0, v1);
          const f32x2 kk = *(const f32x2*)(p.k_k + cc);
          const float f0 = v0 * kk.x, f1 = v1 * kk.y;
          float ss = f0 * f0 + f1 * f1;
#pragma unroll
          for (int o = 1; o < 32; o <<= 1) ss += __shfl_xor(ss, o);
          const float rn = rsqrtf(fmaxf(ss, 1e-12f));
          *(u32*)(KK + (size_t)t * 512 + cc) = pk2(f0 * rn, f1 * rn);
        } else if (it < 12) {
          *(u32*)(VS + (size_t)t * 512 + (c - 1024)) = pk2(v0, v1);
        } else if (it == 12) {
          *(u32*)(LIN + (size_t)t * 384 + (c - 1536)) = pk2(tanhf(v0), tanhf(v1));
        } else if (it == 13) {
          *(u32*)(LIN + (size_t)t * 384 + (c - 1536)) = pk2(v0, v1);
        } else {
          *(u32*)(LIN + (size_t)t * 384 + (c - 1536)) = pk2(sigmoidf_(v0), sigmoidf_(v1));
        }
      }
    }
  }
  grid.sync();
  if (STOP == 2) { digest(p, 2, bid, nb, tid); return; }

  {
    const bf16_t* LIN = (const bf16_t*)(ws + O_LIN);
    const bf16_t* W2T = (const bf16_t*)(ws + O_W2T);
    const bf16_t* A2T = (const bf16_t*)(ws + O_A2T);
    const bf16_t* G2T = (const bf16_t*)(ws + O_G2T);
    for (int d = 0; d < 2; ++d) {
      EpiLora ee{0, p.w0 + d * 512, (bf16_t*)(ws + (d ? O_E1 : O_E0))};
      gemm_phase<false>(LIN + d * 64, 384, W2T + d * 512 * 64, 64, 64, 4, 0, 4, lds, ee, bid, nb, tid);
      EpiLora ea{1, p.a0 + d * 512, (bf16_t*)(ws + (d ? O_A1 : O_A0))};
      gemm_phase<false>(LIN + 128 + d * 64, 384, A2T + d * 512 * 64, 64, 64, 4, 0, 4, lds, ea, bid, nb, tid);
    }
    EpiLora eg{2, nullptr, (bf16_t*)(ws + O_GG)};
    gemm_phase<false>(LIN + 256, 384, G2T, 128, 128, 4, 0, 4, lds, eg, bid, nb, tid);
  }
  grid.sync();
  if (STOP == 3) { digest(p, 3, bid, nb, tid); return; }

  {
    const float lam = misc[0];
    const int grp = bid & 7;
    int* counter = (int*)misc + 16 + grp * 16;
    for (;;) {
      if (tid == 0) s_item = atomicAdd(counter, 1);
      __syncthreads();
      const int item = s_item;
      __syncthreads();
      if (item >= 16 + 256) break;
      if (item < 16) scan_chain(p, grp * 16 + item, lds, tid);
      else attn_item(p, grp * 256 + (item - 16), lam, lds, tid);
    }
  }
  grid.sync();

  {
    const float* Y0 = p.out;
    const float* Y1 = p.out + (size_t)T * 512;
    const bf16_t* RS = (const bf16_t*)(ws + O_RS);
    const bf16_t* KS = (const bf16_t*)(ws + O_KS);
    const bf16_t* VS = (const bf16_t*)(ws + O_VS);
    const bf16_t* A0 = (const bf16_t*)(ws + O_A0);
    const bf16_t* A1 = (const bf16_t*)(ws + O_A1);
    const bf16_t* GG = (const bf16_t*)(ws + O_GG);
    bf16_t* YC = (bf16_t*)(ws + O_YCAT);
    for (int idx = gw; idx < T * 8; idx += ngw) {
      const int t = idx >> 3, h = idx & 7, c = h * 64 + lane;
      const size_t o = (size_t)t * 512 + c;
      const float y = Y0[o] + Y1[o];
      const float mean = wave_sum(y) * (1.f / 64.f);
      const float dl = y - mean;
      const float var = wave_sum(dl * dl) * (1.f / 64.f);
      const float yn = dl * rsqrtf(var + 64e-5f) * p.gn_w[c] + p.gn_b[c];
      const float r = bf2f(RS[o]), k = bf2f(KS[o]), v = bf2f(VS[o]), a0 = bf2f(A0[o]), a1 = bf2f(A1[o]), g = bf2f(GG[o]);
      const float ka = p.k_a[c];
      const float kd = k * (2.f + (a0 + a1 - 2.f) * ka);
      const float bs = wave_sum(r * kd * p.r_k[c]);
      YC[(size_t)t * 1024 + 512 + c] = f2bf((yn + bs * v) * g);
    }
  }
  grid.sync();
  if (STOP == 6) { digest(p, 6, bid, nb, tid); return; }

  {
    EpiF32 e{(float*)(ws + O_MIX), D};
    gemm_phase<false>((const bf16_t*)(ws + O_YCAT), D, (const bf16_t*)(ws + O_WOUTT), D, D, 8, 0, 8, lds, e, bid, nb, tid);
  }
  grid.sync();

  {
    const float* mix = (const float*)(ws + O_MIX);
    bf16_t* x1b = (bf16_t*)(ws + O_X1B);
    for (int row = gw; row < T; row += ngw) {
      const f32x4* mr = (const f32x4*)(mix + (size_t)row * D) + lane;
      const f32x4* xr = (const f32x4*)(p.x + (size_t)row * D) + lane;
      const f32x4* gr = (const f32x4*)(p.post_mix) + lane;
      f32x4 mv[4];
      float s = 0.f;
#pragma unroll
      for (int j = 0; j < 4; ++j) {
        mv[j] = mr[64 * j];
        s += mv[j][0] * mv[j][0] + mv[j][1] * mv[j][1] + mv[j][2] * mv[j][2] + mv[j][3] * mv[j][3];
      }
      const float rs = rsqrtf(wave_sum(s) * (1.f / D) + 1e-6f);
      float s2 = 0.f;
      f32x4* orow = (f32x4*)(p.out + (size_t)row * D) + lane;
#pragma unroll
      for (int j = 0; j < 4; ++j) {
        mv[j] = xr[64 * j] + mv[j] * rs * gr[64 * j];
        s2 += mv[j][0] * mv[j][0] + mv[j][1] * mv[j][1] + mv[j][2] * mv[j][2] + mv[j][3] * mv[j][3];
        orow[64 * j] = mv[j];
        st_bf4(x1b + (size_t)row * D + lane * 4 + 256 * j, mv[j]);
      }
      s2 = wave_sum(s2);
      if (lane == 0) rstd2[row] = rsqrtf(s2 * (1.f / D) + 1e-6f);
    }
  }
  grid.sync();

  {
    EpiGate e{rstd2, (bf16_t*)(ws + O_G)};
    gemm_phase<false>((const bf16_t*)(ws + O_X1B), D, (const bf16_t*)(ws + O_WUPT), D, D, 22, 0, 22, lds, e, bid, nb, tid);
  }
  grid.sync();

  {
    EpiUp e{rstd2, (const bf16_t*)(ws + O_G), p.conv_w, p.conv_b, (bf16_t*)(ws + O_ACT)};
    gemm_phase<false>((const bf16_t*)(ws + O_X1B), D, (const bf16_t*)(ws + O_WUPT) + (size_t)DFF * D, D, D, 22, 0, 22, lds, e, bid, nb, tid);
  }
  grid.sync();

  {
    EpiF32 e{(float*)(ws + O_F), D};
    gemm_phase<false>((const bf16_t*)(ws + O_ACT), DFF, (const bf16_t*)(ws + O_WDOWNT), DFF, DFF, 8, 0, 8, lds, e, bid, nb, tid);
  }
  grid.sync();

  {
    const float* f = (const float*)(ws + O_F);
    for (int row = gw; row < T; row += ngw) {
      const f32x4* fr_ = (const f32x4*)(f + (size_t)row * D) + lane;
      const f32x4* gr = (const f32x4*)(p.post_ffn) + lane;
      f32x4* orow = (f32x4*)(p.out + (size_t)row * D) + lane;
      f32x4 fv[4];
      float s = 0.f;
#pragma unroll
      for (int j = 0; j < 4; ++j) {
        fv[j] = fr_[64 * j];
        s += fv[j][0] * fv[j][0] + fv[j][1] * fv[j][1] + fv[j][2] * fv[j][2] + fv[j][3] * fv[j][3];
      }
      const float rs = rsqrtf(wave_sum(s) * (1.f / D) + 1e-6f);
#pragma unroll
      for (int j = 0; j < 4; ++j) orow[64 * j] = orow[64 * j] + fv[j] * rs * gr[64 * j];
    }
  }
}

extern "C" void kernel_launch(void* const* d_in, const int* in_sizes, int n_in, void* d_out, int out_size, void* d_ws, size_t ws_size,
                              hipStream_t stream) {
  static int grid_blocks = 0;
  if (grid_blocks == 0) {
    if (n_in != 27 || in_sizes[0] != T * D || out_size != T * D || ws_size < WS_END) {
      fprintf(stderr, "kernel_launch: unexpected shapes (n_in %d, in0 %d, out %d, ws %zu)\n", n_in, n_in > 0 ? in_sizes[0] : -1, out_size, ws_size);
      grid_blocks = -1;
      return;
    }
    int dev = 0, cus = 0, per_cu = 0;
    (void)hipGetDevice(&dev);
    (void)hipDeviceGetAttribute(&cus, hipDeviceAttributeMultiprocessorCount, dev);
    (void)hipFuncSetAttribute((const void*)mega, hipFuncAttributeMaxDynamicSharedMemorySize, LDS_BYTES);
    (void)hipOccupancyMaxActiveBlocksPerMultiprocessor(&per_cu, (const void*)mega, 512, LDS_BYTES);
    if (per_cu < 1) per_cu = 1;
    grid_blocks = cus * per_cu;
  }
  if (grid_blocks < 0) return;
  Params p{};
  const float** pp = (const float**)&p;
  for (int i = 0; i < 27; ++i) pp[i] = (const float*)d_in[i];
  p.out = (float*)d_out;
  p.ws = (unsigned char*)d_ws;
  void* args[] = {&p};
  hipError_t e = hipLaunchCooperativeKernel((const void*)mega, dim3(grid_blocks), dim3(512), args, LDS_BYTES, stream);
  if (e != hipSuccess) fprintf(stderr, "cooperative launch failed: %s (grid %d)\n", hipGetErrorString(e), grid_blocks);
}
```

```cpp
#include <hip/hip_runtime.h>
#include <hip/hip_cooperative_groups.h>
#include <cstdio>
namespace cg = cooperative_groups;

typedef unsigned short bf16_t;
typedef short bf16x8 __attribute__((ext_vector_type(8)));
typedef float f32x4 __attribute__((ext_vector_type(4)));
typedef float f32x2 __attribute__((ext_vector_type(2)));
typedef unsigned int u32;
typedef u32 u32x4 __attribute__((ext_vector_type(4)));
typedef u32 u32x2 __attribute__((ext_vector_type(2)));

#define DI __device__ __forceinline__

constexpr int T = 65536, S = 8192, D = 1024, NIN = 3456, NRW = 1920, DFF = 2816;
constexpr size_t MiB = 1ull << 20;
constexpr size_t O_WINT = 0, O_WOUTT = 7 * MiB, O_WUPT = 9 * MiB, O_WDOWNT = 20 * MiB;
constexpr size_t O_W2T = 26 * MiB, O_A2T = O_W2T + 131072, O_G2T = O_W2T + 262144;
constexpr size_t O_ROPE = 27 * MiB, O_RSTD1 = 29 * MiB, O_RSTD2 = O_RSTD1 + 262144, O_MISC = 30 * MiB;
constexpr size_t O_XB = 32 * MiB, O_LIN = 32 * MiB, O_YCAT = 32 * MiB, O_ACT = 32 * MiB;
constexpr size_t O_QK = 160 * MiB, O_VT = 288 * MiB, O_MIX = 160 * MiB;
constexpr size_t O_Z = 352 * MiB, O_E0 = 352 * MiB, O_E1 = 416 * MiB, O_A0 = 480 * MiB, O_A1 = 544 * MiB, O_GG = 608 * MiB;
constexpr size_t O_RS = 672 * MiB, O_KS = 736 * MiB, O_VS = 800 * MiB, O_KK = 864 * MiB;
constexpr size_t O_X1B = 416 * MiB, O_G = 544 * MiB, O_F = 544 * MiB;
constexpr size_t WS_END = 928 * MiB;

constexpr int LDS_BYTES = 114688;
constexpr float QSCALE = 0.125f * 1.4426950408889634f;

struct Params {
  const float *x, *pre_mix, *post_mix, *pre_ffn, *post_ffn, *w_in, *lq1, *lk1, *lq2, *lk2, *subln, *mu, *w0, *w2, *a0, *a2, *g2,
      *k_k, *k_a, *r_k, *gn_w, *gn_b, *w_out, *w_up, *conv_w, *conv_b, *w_down;
  float* out;
  unsigned char* ws;
};

typedef __bf16 bf16x2_t __attribute__((ext_vector_type(2)));
DI u32 pk2(float lo, float hi) {
  f32x2 f = {lo, hi};
  bf16x2_t b = __builtin_convertvector(f, bf16x2_t);
  return __builtin_bit_cast(u32, b);
}
DI bf16_t f2bf(float f) { return (bf16_t)(pk2(f, 0.f) & 0xffffu); }
DI float bf2f(u32 h) { return __uint_as_float(h << 16); }
DI float bflo(u32 w) { return __uint_as_float(w << 16); }
DI float bfhi(u32 w) { return __uint_as_float(w & 0xffff0000u); }
DI void st_bf4(bf16_t* p, f32x4 v) {
  u32x2 o;
  o.x = pk2(v[0], v[1]);
  o.y = pk2(v[2], v[3]);
  *(u32x2*)p = o;
}
DI float wave_sum(float v) {
#pragma unroll
  for (int o = 1; o < 64; o <<= 1) v += __shfl_xor(v, o);
  return v;
}
DI float sigmoidf_(float u) { return 1.f / (1.f + __expf(-u)); }
template <int CTRL>
DI float dppf(float v) {
  return __builtin_bit_cast(float, __builtin_amdgcn_update_dpp(0, __builtin_bit_cast(int, v), CTRL, 0xF, 0xF, true));
}
DI float row_sum16(float v) {
  v += dppf<0x128>(v);
  v += dppf<0x124>(v);
  v += dppf<0x122>(v);
  v += dppf<0x121>(v);
  return v;
}


DI void gsync(unsigned* bar, unsigned target) {
  __threadfence();
  __syncthreads();
  if (threadIdx.x == 0) {
    __hip_atomic_fetch_add(bar, 1u, __ATOMIC_RELEASE, __HIP_MEMORY_SCOPE_AGENT);
    while (__hip_atomic_load(bar, __ATOMIC_RELAXED, __HIP_MEMORY_SCOPE_AGENT) < target) __builtin_amdgcn_s_sleep(2);
  }
  __syncthreads();
  __builtin_amdgcn_fence(__ATOMIC_ACQUIRE, "agent");
}

typedef __attribute__((address_space(3))) unsigned int lds_u32;
DI void glds16(const void* g, unsigned char* l) {
  __builtin_amdgcn_global_load_lds((const unsigned*)g, (lds_u32*)l, 16, 0, 0);
}
#define WAIT_VM0() asm volatile("s_waitcnt vmcnt(0)" ::: "memory")
#define RAW_BAR() __builtin_amdgcn_s_barrier()

DI void transpose_job(const float* src, int K, int N, bf16_t* dst, const float* g, bool perm, float* tile, int bid, int nb, int tid) {
  const int nnt = N / 64, nit = (K / 64) * nnt;
  for (int it = bid; it < nit; it += nb) {
    const int kt = it / nnt, nt = it % nnt, k0 = kt * 64, n0 = nt * 64;
#pragma unroll
    for (int i = 0; i < 8; ++i) {
      const int kk = (tid >> 6) + 8 * i, nn = tid & 63;
      float v = src[(size_t)(k0 + kk) * N + n0 + nn];
      if (g) v *= g[k0 + kk];
      tile[kk * 65 + nn] = v;
    }
    __syncthreads();
#pragma unroll
    for (int i = 0; i < 8; ++i) {
      const int nn = (tid >> 6) + 8 * i, kk = tid & 63;
      const int n = n0 + nn;
      int nd = n;
      if (perm && n < 1024) {
        const int d = n & 63;
        nd = (n & ~63) | (2 * (d & 31) + (d >> 5));
      }
      dst[(size_t)nd * K + k0 + kk] = f2bf(tile[kk * 65 + nn]);
    }
    __syncthreads();
  }
}

constexpr int G_ASTAGE = 256 * 128, G_BSTAGE = 128 * 128, G_STAGE = G_ASTAGE + G_BSTAGE;

template <bool SWAP, class Epi>
DI void gemm_tile(const bf16_t* __restrict__ A, int lda, const bf16_t* __restrict__ Bt, int ldb, int K, int m0, int n0,
                  unsigned char* lds, const Epi& epi, int tid) {
  const int lane = tid & 63, wave = tid >> 6, wm = wave >> 1, wn = wave & 1, fr = lane & 15, fg = lane >> 4;
  f32x4 acc[4][4];
#pragma unroll
  for (int i = 0; i < 4; ++i)
#pragma unroll
    for (int j = 0; j < 4; ++j) acc[i][j] = (f32x4){0.f, 0.f, 0.f, 0.f};
  const int nk = K / 64;
  const int srow = tid >> 3, skc = tid & 7;
  const int gch = skc ^ ((srow >> 1) & 7);
  const int frs = (fr >> 1) & 7;
  const bf16_t* ga = A + (size_t)(m0 + srow) * lda + gch * 8;
  const bf16_t* gb = Bt + (size_t)(n0 + srow) * ldb + gch * 8;
  unsigned char* lw = lds + tid * 16;
#pragma unroll
  for (int i = 0; i < 4; ++i) glds16(ga + (size_t)(64 * i) * lda, lw + i * 8192);
#pragma unroll
  for (int i = 0; i < 2; ++i) glds16(gb + (size_t)(64 * i) * ldb, lw + G_ASTAGE + i * 8192);
  WAIT_VM0();
  RAW_BAR();
  for (int kt = 0; kt < nk; ++kt) {
    if (kt + 1 < nk) {
      unsigned char* l2 = lw + ((kt + 1) & 1) * G_STAGE;
#pragma unroll
      for (int i = 0; i < 4; ++i) glds16(ga + (size_t)(64 * i) * lda + (kt + 1) * 64, l2 + i * 8192);
#pragma unroll
      for (int i = 0; i < 2; ++i) glds16(gb + (size_t)(64 * i) * ldb + (kt + 1) * 64, l2 + G_ASTAGE + i * 8192);
    }
    const unsigned char* as = lds + (kt & 1) * G_STAGE;
    const unsigned char* bs = as + G_ASTAGE;
#pragma unroll
    for (int ks = 0; ks < 2; ++ks) {
      bf16x8 af[4], bfr[4];
#pragma unroll
      for (int i = 0; i < 4; ++i) af[i] = *(const bf16x8*)(as + (wm * 64 + i * 16 + fr) * 128 + (((ks * 4 + fg) ^ frs) * 16));
#pragma unroll
      for (int i = 0; i < 4; ++i) bfr[i] = *(const bf16x8*)(bs + (wn * 64 + i * 16 + fr) * 128 + (((ks * 4 + fg) ^ frs) * 16));
#pragma unroll
      for (int mi = 0; mi < 4; ++mi)
#pragma unroll
        for (int ni = 0; ni < 4; ++ni) {
          if (SWAP) acc[mi][ni] = __builtin_amdgcn_mfma_f32_16x16x32_bf16(af[mi], bfr[ni], acc[mi][ni], 0, 0, 0);
          else acc[mi][ni] = __builtin_amdgcn_mfma_f32_16x16x32_bf16(bfr[ni], af[mi], acc[mi][ni], 0, 0, 0);
        }
    }
    WAIT_VM0();
    RAW_BAR();
  }
#pragma unroll
  for (int mi = 0; mi < 4; ++mi)
#pragma unroll
    for (int ni = 0; ni < 4; ++ni) {
      if (SWAP) epi(m0 + wm * 64 + mi * 16 + fg * 4, n0 + wn * 64 + ni * 16 + fr, acc[mi][ni]);
      else epi(m0 + wm * 64 + mi * 16 + fr, n0 + wn * 64 + ni * 16 + fg * 4, acc[mi][ni]);
    }
}

struct EpiInProj {
  const float* rstd; const f32x2* rope; bf16_t* qk; bf16_t* z;
  DI void operator()(int m, int n, f32x4 v) const {
    const float rs = rstd[m];
    v = v * rs;
    if (n < 1024) {
      const int s = m & (S - 1), i = (n & 63) >> 1;
      const f32x2 c0 = rope[s * 32 + i], c1 = rope[s * 32 + i + 1];
      float a = v[0], b = v[1];
      v[0] = a * c0.x - b * c0.y; v[1] = b * c0.x + a * c0.y;
      a = v[2]; b = v[3];
      v[2] = a * c1.x - b * c1.y; v[3] = b * c1.x + a * c1.y;
      if (n < 512) v = v * QSCALE;
      st_bf4(qk + (size_t)m * 1024 + n, v);
    } else {
      st_bf4(z + (size_t)m * NRW + (n - 1536), v);
    }
  }
};
struct EpiV {
  const float* rstd; bf16_t* vt;
  DI void operator()(int m, int n, f32x4 v) const {
    const f32x4 rs = *(const f32x4*)(rstd + m);
    v = v * rs;
    const int nn = n - 1024, h = nn >> 7, vd = nn & 127, b = m >> 13, s = m & (S - 1);
    st_bf4(vt + ((size_t)((b * 4 + h) * 128 + vd)) * S + s, v);
  }
};
struct EpiLora {
  int mode; const float* bias; bf16_t* out;
  DI void operator()(int m, int n, f32x4 v) const {
    if (mode < 2) {
      const f32x4 bv = *(const f32x4*)(bias + n);
      const float sc = mode == 0 ? 0.60653065971f : 1.f;
#pragma unroll
      for (int j = 0; j < 4; ++j) v[j] = sc * sigmoidf_(v[j] + bv[j]);
    }
    st_bf4(out + (size_t)m * 512 + n, v);
  }
};
struct EpiF32 {
  float* out; int ld;
  DI void operator()(int m, int n, f32x4 v) const { *(f32x4*)(out + (size_t)m * ld + n) = v; }
};
struct EpiGate {
  const float* rstd; bf16_t* g;
  DI void operator()(int m, int n, f32x4 v) const { st_bf4(g + (size_t)m * DFF + n, v * rstd[m]); }
};
struct EpiUp {
  const float* rstd; const bf16_t* g; const float* cw; const float* cb; bf16_t* act;
  DI void operator()(int m, int n, f32x4 v) const {
    v = v * rstd[m];
    const int s = m & (S - 1);
    const bf16_t* gp = g + (size_t)m * DFF + n;
    const u32x2 g0 = *(const u32x2*)gp;
    u32x2 gm = (u32x2){0u, 0u}, gn = (u32x2){0u, 0u};
    if (s > 0) gm = *(const u32x2*)(gp - DFF);
    if (s < S - 1) gn = *(const u32x2*)(gp + DFF);
    const f32x4 w0 = *(const f32x4*)(cw + n), w1 = *(const f32x4*)(cw + DFF + n), w2 = *(const f32x4*)(cw + 2 * DFF + n), bb = *(const f32x4*)(cb + n);
    f32x4 c, p, q;
    c[0] = bflo(g0.x); c[1] = bfhi(g0.x); c[2] = bflo(g0.y); c[3] = bfhi(g0.y);
    p[0] = bflo(gm.x); p[1] = bfhi(gm.x); p[2] = bflo(gm.y); p[3] = bfhi(gm.y);
    q[0] = bflo(gn.x); q[1] = bfhi(gn.x); q[2] = bflo(gn.y); q[3] = bfhi(gn.y);
    f32x4 o;
#pragma unroll
    for (int j = 0; j < 4; ++j) {
      const float xg = w0[j] * p[j] + w1[j] * c[j] + w2[j] * q[j] + bb[j];
      const float y = 0.7978845608028654f * (xg + 0.044715f * xg * xg * xg);
      o[j] = xg / (1.f + __expf(-2.f * y)) * v[j];
    }
    st_bf4(act + (size_t)m * DFF + n, o);
  }
};

DI bool tile_of(int r, int bid, int nb, int w, int& mt, int& n) {
  if (nb == 256) {
    if (r >= w) return false;
    const int grp = bid & 7, j = bid >> 3, L = r * 32 + j, g = L / (w * 8), rem = L - g * w * 8;
    n = rem >> 3;
    mt = grp * 32 + g * 8 + (rem & 7);
    return true;
  }
  const int total = 256 * w, per = (total + nb - 1) / nb, it = bid * per + r;
  if (r >= per || it >= total) return false;
  mt = it / w;
  n = it % w;
  return true;
}
template <bool SWAP, class Epi>
DI void gemm_phase(const bf16_t* A, int lda, const bf16_t* Bt, int ldb, int K, int ntn, int nt_lo, int nt_hi, unsigned char* lds, const Epi& epi,
                   int bid, int nb, int tid) {
  const int w = nt_hi - nt_lo;
  for (int r = 0;; ++r) {
    int mt, n;
    if (!tile_of(r, bid, nb, w, mt, n)) break;
    gemm_tile<SWAP>(A, lda, Bt, ldb, K, mt * 256, (nt_lo + n) * 128, lds, epi, tid);
  }
}

DI void scan_chain(const Params& p, int chain, unsigned char* lds, int tid) {
  const int d = chain & 1, h = (chain >> 1) & 7, b = chain >> 4;
  float* rec = (float*)lds;
  float* ybuf = (float*)(lds + 98304);
  const bf16_t* RS = (const bf16_t*)(p.ws + O_RS);
  const bf16_t* KS = (const bf16_t*)(p.ws + O_KS);
  const bf16_t* VS = (const bf16_t*)(p.ws + O_VS);
  const bf16_t* KK = (const bf16_t*)(p.ws + O_KK);
  const bf16_t* EE = (const bf16_t*)(p.ws + (d ? O_E1 : O_E0));
  const bf16_t* AA = (const bf16_t*)(p.ws + (d ? O_A1 : O_A0));
  float* Y = p.out + (size_t)d * T * 512;
  const int lane = tid & 63, wave = tid >> 6, cgi = lane & 15, rg = lane >> 4, row0 = wave * 8 + rg * 2;
  const float ka = p.k_a[h * 64 + lane];
  float S0[4] = {0.f, 0.f, 0.f, 0.f}, S1[4] = {0.f, 0.f, 0.f, 0.f};
  bf16_t pr[4][6];
  const int ch = h * 64 + lane;
#define SCAN_TOK(n, k) ((size_t)(b * S + (d ? (S - 1 - ((n) * 32 + (k))) : ((n) * 32 + (k)))))
#define SCAN_LOAD(n)                                                      \
  _Pragma("unroll") for (int i = 0; i < 4; ++i) {                         \
    const size_t o_ = SCAN_TOK(n, wave + 8 * i) * 512 + ch;               \
    pr[i][0] = RS[o_]; pr[i][1] = KS[o_]; pr[i][2] = VS[o_];              \
    pr[i][3] = KK[o_]; pr[i][4] = EE[o_]; pr[i][5] = AA[o_];              \
  }
#define SCAN_XFORM(buf)                                                   \
  _Pragma("unroll") for (int i = 0; i < 4; ++i) {                         \
    float* R_ = rec + (buf) * 12288 + (wave + 8 * i) * 384 + lane;        \
    const float r_ = bf2f(pr[i][0]), k_ = bf2f(pr[i][1]), v_ = bf2f(pr[i][2]), kk_ = bf2f(pr[i][3]), e_ = bf2f(pr[i][4]), a_ = bf2f(pr[i][5]); \
    R_[0] = __expf(-e_); R_[64] = kk_; R_[128] = kk_ * a_; R_[192] = k_ * (1.f + (a_ - 1.f) * ka); R_[256] = r_; R_[320] = v_; \
  }
  SCAN_LOAD(0);
  SCAN_XFORM(0);
  __syncthreads();
  for (int n = 0; n < 256; ++n) {
    if (n + 1 < 256) { SCAN_LOAD(n + 1); }
    __builtin_amdgcn_sched_barrier(0);
    const float* RB = rec + (n & 1) * 12288;
    float* YB = ybuf + (n & 1) * 2048;
#pragma unroll 4
    for (int k = 0; k < 32; ++k) {
      const float* R = RB + k * 384;
      const f32x4 w4 = *(const f32x4*)(R + cgi * 4), kk4 = *(const f32x4*)(R + 64 + cgi * 4), b4 = *(const f32x4*)(R + 128 + cgi * 4),
                  kd4 = *(const f32x4*)(R + 192 + cgi * 4), r4 = *(const f32x4*)(R + 256 + cgi * 4);
      const f32x2 v2 = *(const f32x2*)(R + 320 + row0);
      float d0 = S0[0] * kk4[0] + S0[1] * kk4[1] + S0[2] * kk4[2] + S0[3] * kk4[3];
      float d1 = S1[0] * kk4[0] + S1[1] * kk4[1] + S1[2] * kk4[2] + S1[3] * kk4[3];
      d0 = row_sum16(d0);
      d1 = row_sum16(d1);
      float y0 = 0.f, y1 = 0.f;
#pragma unroll
      for (int c = 0; c < 4; ++c) {
        S0[c] = S0[c] * w4[c] + (v2.x * kd4[c] - d0 * b4[c]);
        S1[c] = S1[c] * w4[c] + (v2.y * kd4[c] - d1 * b4[c]);
        y0 += S0[c] * r4[c];
        y1 += S1[c] * r4[c];
      }
      y0 = row_sum16(y0);
      y1 = row_sum16(y1);
      if (cgi == 0) *(f32x2*)(YB + k * 64 + row0) = (f32x2){y0, y1};
    }
    if (n + 1 < 256) { SCAN_XFORM((n + 1) & 1); }
    __syncthreads();
    {
      const int k = tid >> 4, c4 = (tid & 15) * 4;
      *(f32x4*)(Y + SCAN_TOK(n, k) * 512 + h * 64 + c4) = *(const f32x4*)(YB + k * 64 + c4);
    }
  }
  __syncthreads();
#undef SCAN_TOK
#undef SCAN_LOAD
#undef SCAN_XFORM
}

constexpr int AT_K = 64 * 256, AT_V = 128 * 128, AT_STAGE = AT_K + AT_V;

DI void attn_item(const Params& p, int item, float lam, unsigned char* lds, int tid) {
  const int qb = item & 63, bh = item >> 6, h = bh & 3, b = bh >> 2;
  const int lane = tid & 63, wave = tid >> 6, fr = lane & 15, fg = lane >> 4;
  const bf16_t* QK = (const bf16_t*)(p.ws + O_QK);
  const bf16_t* VT = (const bf16_t*)(p.ws + O_VT);
  bf16_t* YC = (bf16_t*)(p.ws + O_YCAT);
  const int q0 = b * S + qb * 128 + wave * 16;
  bf16x8 qf[2][2];
#pragma unroll
  for (int c = 0; c < 2; ++c)
#pragma unroll
    for (int ks = 0; ks < 2; ++ks) qf[c][ks] = *(const bf16x8*)(QK + (size_t)(q0 + fr) * 1024 + h * 128 + c * 64 + ks * 32 + fg * 8);
  f32x4 o[2][8];
#pragma unroll
  for (int c = 0; c < 2; ++c)
#pragma unroll
    for (int i = 0; i < 8; ++i) o[c][i] = (f32x4){0.f, 0.f, 0.f, 0.f};
  float mrun[2] = {-1e30f, -1e30f}, lrun[2] = {0.f, 0.f};
  const int krow = tid >> 4, kkc = tid & 15;
  const int vrow = tid >> 3, vkc = tid & 7;
  const int kgc = kkc ^ ((((krow & 31) >> 3) << 2) | (krow & 3));
  const int vgc = vkc ^ ((vrow >> 1) & 7);
  const int krd = ((fr >> 2) * 8 + (fr & 3)) * 256;
  const int vrd = AT_K + fr * 128;
  const int frs = (fr >> 1) & 7;
  const bf16_t* gk = QK + (size_t)(b * S + krow) * 1024 + 512 + h * 128 + kgc * 8;
  const bf16_t* gv = VT + (size_t)((b * 4 + h) * 128 + vrow) * S + vgc * 8;
  unsigned char* lw = lds + tid * 16;
#pragma unroll
  for (int i = 0; i < 2; ++i) {
    glds16(gk + (size_t)(32 * i) * 1024, lw + i * 8192);
    glds16(gv + (size_t)(64 * i) * S, lw + AT_K + i * 8192);
  }
  WAIT_VM0();
  RAW_BAR();
  for (int kt = 0; kt < 128; ++kt) {
    if (kt + 1 < 128) {
      unsigned char* l2 = lw + ((kt + 1) & 1) * AT_STAGE;
#pragma unroll
      for (int i = 0; i < 2; ++i) {
        glds16(gk + (size_t)((kt + 1) * 64 + 32 * i) * 1024, l2 + i * 8192);
        glds16(gv + (size_t)(64 * i) * S + (kt + 1) * 64, l2 + AT_K + i * 8192);
      }
    }
    const unsigned char* sm = lds + (kt & 1) * AT_STAGE;
    bf16x8 pf[2][2];
#pragma unroll
    for (int c = 0; c < 2; ++c) {
      f32x4 s[4];
#pragma unroll
      for (int t4 = 0; t4 < 4; ++t4) {
        s[t4] = (f32x4){0.f, 0.f, 0.f, 0.f};
#pragma unroll
        for (int ks = 0; ks < 2; ++ks) {
          const bf16x8 kf = *(const bf16x8*)(sm + krd + ((t4 >> 1) * 32 + (t4 & 1) * 4) * 256 + (((c * 8 + ks * 4 + fg) ^ fr) * 16));
          s[t4] = __builtin_amdgcn_mfma_f32_16x16x32_bf16(kf, qf[c][ks], s[t4], 0, 0, 0);
        }
      }
      float mx = fmaxf(fmaxf(s[0][0], s[0][1]), fmaxf(s[0][2], s[0][3]));
#pragma unroll
      for (int t4 = 1; t4 < 4; ++t4) mx = fmaxf(mx, fmaxf(fmaxf(s[t4][0], s[t4][1]), fmaxf(s[t4][2], s[t4][3])));
      if (__any(mx > mrun[c] + 8.f)) {
        mx = fmaxf(mx, __shfl_xor(mx, 16));
        mx = fmaxf(mx, __shfl_xor(mx, 32));
        const float mn = fmaxf(mrun[c], mx);
        const float alpha = __builtin_amdgcn_exp2f(mrun[c] - mn);
        mrun[c] = mn;
        lrun[c] *= alpha;
#pragma unroll
        for (int i = 0; i < 8; ++i) o[c][i] = o[c][i] * alpha;
      }
      const float mr = mrun[c];
      float ps = 0.f;
#pragma unroll
      for (int t4 = 0; t4 < 4; ++t4)
#pragma unroll
        for (int j = 0; j < 4; ++j) {
          s[t4][j] = __builtin_amdgcn_exp2f(s[t4][j] - mr);
          ps += s[t4][j];
        }
      lrun[c] += ps;
#pragma unroll
      for (int kb = 0; kb < 2; ++kb) {
        u32x4 w;
        w.x = pk2(s[2 * kb][0], s[2 * kb][1]);
        w.y = pk2(s[2 * kb][2], s[2 * kb][3]);
        w.z = pk2(s[2 * kb + 1][0], s[2 * kb + 1][1]);
        w.w = pk2(s[2 * kb + 1][2], s[2 * kb + 1][3]);
        pf[c][kb] = __builtin_bit_cast(bf16x8, w);
      }
    }
#pragma unroll
    for (int vt = 0; vt < 8; ++vt)
#pragma unroll
      for (int kb = 0; kb < 2; ++kb) {
        const bf16x8 vf = *(const bf16x8*)(sm + vrd + vt * 16 * 128 + (((kb * 4 + fg) ^ frs) * 16));
        o[0][vt] = __builtin_amdgcn_mfma_f32_16x16x32_bf16(vf, pf[0][kb], o[0][vt], 0, 0, 0);
        o[1][vt] = __builtin_amdgcn_mfma_f32_16x16x32_bf16(vf, pf[1][kb], o[1][vt], 0, 0, 0);
      }
    WAIT_VM0();
    RAW_BAR();
  }
  float l0 = lrun[0], l1 = lrun[1];
  l0 += __shfl_xor(l0, 16); l0 += __shfl_xor(l0, 32);
  l1 += __shfl_xor(l1, 16); l1 += __shfl_xor(l1, 32);
  const float i0 = 1.f / l0, i1 = lam / l1;
  float ss = 0.f;
#pragma unroll
  for (int vt = 0; vt < 8; ++vt) {
    o[0][vt] = o[0][vt] * i0 - o[1][vt] * i1;
#pragma unroll
    for (int j = 0; j < 4; ++j) ss += o[0][vt][j] * o[0][vt][j];
  }
  ss += __shfl_xor(ss, 16);
  ss += __shfl_xor(ss, 32);
  const float rs = rsqrtf(ss * (1.f / 128.f) + 1e-6f) * 0.8f;
#pragma unroll
  for (int vt = 0; vt < 8; ++vt) {
    const int vd = vt * 16 + fg * 4;
    const f32x4 g4 = *(const f32x4*)(p.subln + vd);
    st_bf4(YC + (size_t)(q0 + fr) * 1024 + h * 128 + vd, o[0][vt] * g4 * rs);
  }
}


#ifndef STOP
#define STOP 99
#endif
DI void digest(const Params& p, int which, int bid, int nb, int tid) {
  const unsigned char* ws = p.ws;
  for (size_t i = (size_t)bid * 512 + tid; i < (size_t)T * 1024; i += (size_t)nb * 512) {
    const size_t t = i >> 10; const int c = (int)(i & 1023);
    float v = 0.f;
    if (which == 3) {
      v = bf2f(((const bf16_t*)(ws + O_QK))[i]);
      if (c < 512) {
        const size_t o = t * 512 + c;
        v += bf2f(((const bf16_t*)(ws + O_VT))[o]) + bf2f(((const bf16_t*)(ws + O_RS))[o]) + bf2f(((const bf16_t*)(ws + O_KS))[o]) +
             bf2f(((const bf16_t*)(ws + O_VS))[o]) + bf2f(((const bf16_t*)(ws + O_KK))[o]) + bf2f(((const bf16_t*)(ws + O_E0))[o]) +
             bf2f(((const bf16_t*)(ws + O_E1))[o]) + bf2f(((const bf16_t*)(ws + O_A0))[o]) + bf2f(((const bf16_t*)(ws + O_A1))[o]) +
             bf2f(((const bf16_t*)(ws + O_GG))[o]);
      }
    } else if (which == 0) {
      v = bf2f(((const bf16_t*)(ws + O_XB))[i]) + ((const float*)(ws + O_RSTD1))[t] + bf2f(((const bf16_t*)(ws + O_WINT))[i % (size_t)(3456 * 1024)]) +
          bf2f(((const bf16_t*)(ws + O_WUPT))[i % (size_t)(5632 * 1024)]) + bf2f(((const bf16_t*)(ws + O_WDOWNT))[i % (size_t)(2816 * 1024)]) +
          bf2f(((const bf16_t*)(ws + O_WOUTT))[i % (size_t)(1024 * 1024)]) + bf2f(((const bf16_t*)(ws + O_W2T))[i % (size_t)(196608)]) +
          ((const float*)(ws + O_ROPE))[i % (size_t)(8192 * 64)];
    } else if (which == 1) {
      v = bf2f(((const bf16_t*)(ws + O_QK))[i]);
      if (c < 512) v += bf2f(((const bf16_t*)(ws + O_VT))[t * 512 + c]);
      v += bf2f(((const bf16_t*)(ws + O_Z))[t * 1920 + c]);
      if (c < 896) v += bf2f(((const bf16_t*)(ws + O_Z))[t * 1920 + 1024 + c]);
    } else if (which == 2) {
      if (c < 512) {
        const size_t o = t * 512 + c;
        v = bf2f(((const bf16_t*)(ws + O_RS))[o]) + bf2f(((const bf16_t*)(ws + O_KS))[o]) + bf2f(((const bf16_t*)(ws + O_VS))[o]) + bf2f(((const bf16_t*)(ws + O_KK))[o]);
      } else if (c < 896) v = bf2f(((const bf16_t*)(ws + O_LIN))[t * 384 + c - 512]);
    } else if (which == 6) {
      v = bf2f(((const bf16_t*)(ws + O_YCAT))[i]);
    }
    p.out[i] = v;
  }
}

__global__ void __launch_bounds__(512) mega(Params p) {
  cg::grid_group grid = cg::this_grid();
  extern __shared__ __attribute__((aligned(16))) unsigned char lds[];
  __shared__ int s_item;
  const int tid = threadIdx.x, bid = blockIdx.x, nb = gridDim.x, lane = tid & 63, wave = tid >> 6;
  const int gw = bid * 8 + wave, ngw = nb * 8;
  unsigned char* ws = p.ws;
  float* rstd1 = (float*)(ws + O_RSTD1);
  float* rstd2 = (float*)(ws + O_RSTD2);
  float* misc = (float*)(ws + O_MISC);

  {
    bf16_t* xb = (bf16_t*)(ws + O_XB);
    for (int row = gw; row < T; row += ngw) {
      const f32x4* xr = (const f32x4*)(p.x + (size_t)row * D) + lane;
      f32x4 v[4];
      float s = 0.f;
#pragma unroll
      for (int j = 0; j < 4; ++j) {
        v[j] = xr[64 * j];
        s += v[j][0] * v[j][0] + v[j][1] * v[j][1] + v[j][2] * v[j][2] + v[j][3] * v[j][3];
      }
      s = wave_sum(s);
      if (lane == 0) rstd1[row] = rsqrtf(s * (1.f / D) + 1e-6f);
      bf16_t* orow = xb + (size_t)row * D + lane * 4;
#pragma unroll
      for (int j = 0; j < 4; ++j) st_bf4(orow + 256 * j, v[j]);
    }
    float* tile = (float*)lds;
    transpose_job(p.w_in, D, NIN, (bf16_t*)(ws + O_WINT), p.pre_mix, true, tile, bid, nb, tid);
    transpose_job(p.w_out, D, D, (bf16_t*)(ws + O_WOUTT), nullptr, false, tile, bid, nb, tid);
    transpose_job(p.w_up, D, 2 * DFF, (bf16_t*)(ws + O_WUPT), p.pre_ffn, false, tile, bid, nb, tid);
    transpose_job(p.w_down, DFF, D, (bf16_t*)(ws + O_WDOWNT), nullptr, false, tile, bid, nb, tid);
    transpose_job(p.w2, 64, 512, (bf16_t*)(ws + O_W2T), nullptr, false, tile, bid, nb, tid);
    transpose_job(p.w2 + 64 * 512, 64, 512, (bf16_t*)(ws + O_W2T) + 512 * 64, nullptr, false, tile, bid, nb, tid);
    transpose_job(p.a2, 64, 512, (bf16_t*)(ws + O_A2T), nullptr, false, tile, bid, nb, tid);
    transpose_job(p.a2 + 64 * 512, 64, 512, (bf16_t*)(ws + O_A2T) + 512 * 64, nullptr, false, tile, bid, nb, tid);
    transpose_job(p.g2, 128, 512, (bf16_t*)(ws + O_G2T), nullptr, false, tile, bid, nb, tid);
    f32x2* rope = (f32x2*)(ws + O_ROPE);
    for (int i = bid * 512 + tid; i < S * 32; i += nb * 512) {
      const int s = i >> 5, f = i & 31;
      const float inv = powf(10000.f, -(float)f / 32.f);
      const float ang = (float)s * inv;
      rope[i] = (f32x2){cosf(ang), sinf(ang)};
    }
    if (bid == 0 && tid == 0) {
      float s1 = 0.f, s2 = 0.f;
      for (int i = 0; i < 64; ++i) {
        s1 += p.lq1[i] * p.lk1[i];
        s2 += p.lq2[i] * p.lk2[i];
      }
      misc[0] = expf(s1) - expf(s2) + 0.2f;
      for (int i = 0; i < 8; ++i) ((int*)misc)[16 + i * 16] = 0;
    }
  }
  grid.sync();
  if (STOP == 0) { digest(p, 0, bid, nb, tid); return; }

  {
    const bf16_t* xb = (const bf16_t*)(ws + O_XB);
    const bf16_t* wt = (const bf16_t*)(ws + O_WINT);
    EpiInProj e1{rstd1, (const f32x2*)(ws + O_ROPE), (bf16_t*)(ws + O_QK), (bf16_t*)(ws + O_Z)};
    EpiV ev{rstd1, (bf16_t*)(ws + O_VT)};
    for (int r = 0;; ++r) {
      int mt, nt;
      if (!tile_of(r, bid, nb, 27, mt, nt)) break;
      if (nt >= 8 && nt < 12) gemm_tile<true>(xb, D, wt, D, D, mt * 256, nt * 128, lds, ev, tid);
      else gemm_tile<false>(xb, D, wt, D, D, mt * 256, nt * 128, lds, e1, tid);
    }
  }
  grid.sync();

  {
    const bf16_t* Z = (const bf16_t*)(ws + O_Z);
    bf16_t* RS = (bf16_t*)(ws + O_RS);
    bf16_t* KS = (bf16_t*)(ws + O_KS);
    bf16_t* VS = (bf16_t*)(ws + O_VS);
    bf16_t* KK = (bf16_t*)(ws + O_KK);
    bf16_t* LIN = (bf16_t*)(ws + O_LIN);
    for (int t = gw; t < T; t += ngw) {
      const int s = t & (S - 1);
      const bool hp = s > 0, hn = s < S - 1;
      const bf16_t* zc = Z + (size_t)t * NRW;
#pragma unroll 3
      for (int it = 0; it < 15; ++it) {
        const int c = it * 128 + lane * 2;
        const u32 z0 = *(const u32*)(zc + c);
        const u32 zp = hp ? *(const u32*)(zc + c - NRW) : 0u;
        const u32 zn = hn ? *(const u32*)(zc + c + NRW) : 0u;
        const f32x2 m = *(const f32x2*)(p.mu + c);
        const float a0 = bflo(z0), a1 = bfhi(z0);
        const float v0 = a0 + (0.5f * (bflo(zp) + bflo(zn)) - a0) * m.x;
        const float v1 = a1 + (0.5f * (bfhi(zp) + bfhi(zn)) - a1) * m.y;
        if (it < 4) {
          *(u32*)(RS + (size_t)t * 512 + c) = pk2(v0, v1);
        } else if (it < 8) {
          const int cc = c - 512;
          *(u32*)(KS + (size_t)t * 512 + cc) = pk2(v0, v1);
          const f32x2 kk = *(const f32x2*)(p.k_k + cc);
          const float f0 = v0 * kk.x, f1 = v1 * kk.y;
          float ss = f0 * f0 + f1 * f1;
#pragma unroll
          for (int o = 1; o < 32; o <<= 1) ss += __shfl_xor(ss, o);
          const float rn = rsqrtf(fmaxf(ss, 1e-12f));
          *(u32*)(KK + (size_t)t * 512 + cc) = pk2(f0 * rn, f1 * rn);
        } else if (it < 12) {
          *(u32*)(VS + (size_t)t * 512 + (c - 1024)) = pk2(v0, v1);
        } else if (it == 12) {
          *(u32*)(LIN + (size_t)t * 384 + (c - 1536)) = pk2(tanhf(v0), tanhf(v1));
        } else if (it == 13) {
          *(u32*)(LIN + (size_t)t * 384 + (c - 1536)) = pk2(v0, v1);
        } else {
          *(u32*)(LIN + (size_t)t * 384 + (c - 1536)) = pk2(sigmoidf_(v0), sigmoidf_(v1));
        }
      }
    }
  }
  grid.sync();
  if (STOP == 2) { digest(p, 2, bid, nb, tid); return; }

  {
    const bf16_t* LIN = (const bf16_t*)(ws + O_LIN);
    const bf16_t* W2T = (const bf16_t*)(ws + O_W2T);
    const bf16_t* A2T = (const bf16_t*)(ws + O_A2T);
    const bf16_t* G2T = (const bf16_t*)(ws + O_G2T);
    for (int d = 0; d < 2; ++d) {
      EpiLora ee{0, p.w0 + d * 512, (bf16_t*)(ws + (d ? O_E1 : O_E0))};
      gemm_phase<false>(LIN + d * 64, 384, W2T + d * 512 * 64, 64, 64, 4, 0, 4, lds, ee, bid, nb, tid);
      EpiLora ea{1, p.a0 + d * 512, (bf16_t*)(ws + (d ? O_A1 : O_A0))};
      gemm_phase<false>(LIN + 128 + d * 64, 384, A2T + d * 512 * 64, 64, 64, 4, 0, 4, lds, ea, bid, nb, tid);
    }
    EpiLora eg{2, nullptr, (bf16_t*)(ws + O_GG)};
    gemm_phase<false>(LIN + 256, 384, G2T, 128, 128, 4, 0, 4, lds, eg, bid, nb, tid);
  }
  grid.sync();
  if (STOP == 3) { digest(p, 3, bid, nb, tid); return; }

  {
    const float lam = misc[0];
    const int grp = bid & 7;
    int* counter = (int*)misc + 16 + grp * 16;
    for (;;) {
      if (tid == 0) s_item = atomicAdd(counter, 1);
      __syncthreads();
      const int item = s_item;
      __syncthreads();
      if (item >= 16 + 256) break;
      if (item < 16) scan_chain(p, grp * 16 + item, lds, tid);
      else attn_item(p, grp * 256 + (item - 16), lam, lds, tid);
    }
  }
  grid.sync();

  {
    const float* Y0 = p.out;
    const float* Y1 = p.out + (size_t)T * 512;
    const bf16_t* RS = (const bf16_t*)(ws + O_RS);
    const bf16_t* KS = (const bf16_t*)(ws + O_KS);
    const bf16_t* VS = (const bf16_t*)(ws + O_VS);
    const bf16_t* A0 = (const bf16_t*)(ws + O_A0);
    const bf16_t* A1 = (const bf16_t*)(ws + O_A1);
    const bf16_t* GG = (const bf16_t*)(ws + O_GG);
    bf16_t* YC = (bf16_t*)(ws + O_YCAT);
    for (int idx = gw; idx < T * 8; idx += ngw) {
      const int t = idx >> 3, h = idx & 7, c = h * 64 + lane;
      const size_t o = (size_t)t * 512 + c;
      const float y = Y0[o] + Y1[o];
      const float mean = wave_sum(y) * (1.f / 64.f);
      const float dl = y - mean;
      const float var = wave_sum(dl * dl) * (1.f / 64.f);
      const float yn = dl * rsqrtf(var + 64e-5f) * p.gn_w[c] + p.gn_b[c];
      const float r = bf2f(RS[o]), k = bf2f(KS[o]), v = bf2f(VS[o]), a0 = bf2f(A0[o]), a1 = bf2f(A1[o]), g = bf2f(GG[o]);
      const float ka = p.k_a[c];
      const float kd = k * (2.f + (a0 + a1 - 2.f) * ka);
      const float bs = wave_sum(r * kd * p.r_k[c]);
      YC[(size_t)t * 1024 + 512 + c] = f2bf((yn + bs * v) * g);
    }
  }
  grid.sync();
  if (STOP == 6) { digest(p, 6, bid, nb, tid); return; }

  {
    EpiF32 e{(float*)(ws + O_MIX), D};
    gemm_phase<false>((const bf16_t*)(ws + O_YCAT), D, (const bf16_t*)(ws + O_WOUTT), D, D, 8, 0, 8, lds, e, bid, nb, tid);
  }
  grid.sync();

  {
    const float* mix = (const float*)(ws + O_MIX);
    bf16_t* x1b = (bf16_t*)(ws + O_X1B);
    for (int row = gw; row < T; row += ngw) {
      const f32x4* mr = (const f32x4*)(mix + (size_t)row * D) + lane;
      const f32x4* xr = (const f32x4*)(p.x + (size_t)row * D) + lane;
      const f32x4* gr = (const f32x4*)(p.post_mix) + lane;
      f32x4 mv[4];
      float s = 0.f;
#pragma unroll
      for (int j = 0; j < 4; ++j) {
        mv[j] = mr[64 * j];
        s += mv[j][0] * mv[j][0] + mv[j][1] * mv[j][1] + mv[j][2] * mv[j][2] + mv[j][3] * mv[j][3];
      }
      const float rs = rsqrtf(wave_sum(s) * (1.f / D) + 1e-6f);
      float s2 = 0.f;
      f32x4* orow = (f32x4*)(p.out + (size_t)row * D) + lane;
#pragma unroll
      for (int j = 0; j < 4; ++j) {
        mv[j] = xr[64 * j] + mv[j] * rs * gr[64 * j];
        s2 += mv[j][0] * mv[j][0] + mv[j][1] * mv[j][1] + mv[j][2] * mv[j][2] + mv[j][3] * mv[j][3];
        orow[64 * j] = mv[j];
        st_bf4(x1b + (size_t)row * D + lane * 4 + 256 * j, mv[j]);
      }
      s2 = wave_sum(s2);
      if (lane == 0) rstd2[row] = rsqrtf(s2 * (1.f / D) + 1e-6f);
    }
  }
  grid.sync();

  {
    EpiGate e{rstd2, (bf16_t*)(ws + O_G)};
    gemm_phase<false>((const bf16_t*)(ws + O_X1B), D, (const bf16_t*)(ws + O_WUPT), D, D, 22, 0, 22, lds, e, bid, nb, tid);
  }
  grid.sync();

  {
    EpiUp e{rstd2, (const bf16_t*)(ws + O_G), p.conv_w, p.conv_b, (bf16_t*)(ws + O_ACT)};
    gemm_phase<false>((const bf16_t*)(ws + O_X1B), D, (const bf16_t*)(ws + O_WUPT) + (size_t)DFF * D, D, D, 22, 0, 22, lds, e, bid, nb, tid);
  }
  grid.sync();

  {
    EpiF32 e{(float*)(ws + O_F), D};
    gemm_phase<false>((const bf16_t*)(ws + O_ACT), DFF, (const bf16_t*)(ws + O_WDOWNT), DFF, DFF, 8, 0, 8, lds, e, bid, nb, tid);
  }
  grid.sync();

  {
    const float* f = (const float*)(ws + O_F);
    for (int row = gw; row < T; row += ngw) {
      const f32x4* fr_ = (const f32x4*)(f + (size_t)row * D) + lane;
      const f32x4* gr = (const f32x4*)(p.post_ffn) + lane;
      f32x4* orow = (f32x4*)(p.out + (size_t)row * D) + lane;
      f32x4 fv[4];
      float s = 0.f;
#pragma unroll
      for (int j = 0; j < 4; ++j) {
        fv[j] = fr_[64 * j];
        s += fv[j][0] * fv[j][0] + fv[j][1] * fv[j][1] + fv[j][2] * fv[j][2] + fv[j][3] * fv[j][3];
      }
      const float rs = rsqrtf(wave_sum(s) * (1.f / D) + 1e-6f);
#pragma unroll
      for (int j = 0; j < 4; ++j) orow[64 * j] = orow[64 * j] + fv[j] * rs * gr[64 * j];
    }
  }
}

extern "C" void kernel_launch(void* const* d_in, const int* in_sizes, int n_in, void* d_out, int out_size, void* d_ws, size_t ws_size,
                              hipStream_t stream) {
  static int grid_blocks = 0;
  if (grid_blocks == 0) {
    if (n_in != 27 || in_sizes[0] != T * D || out_size != T * D || ws_size < WS_END) {
      fprintf(stderr, "kernel_launch: unexpected shapes (n_in %d, in0 %d, out %d, ws %zu)\n", n_in, n_in > 0 ? in_sizes[0] : -1, out_size, ws_size);
      grid_blocks = -1;
      return;
    }
    int dev = 0, cus = 0, per_cu = 0;
    (void)hipGetDevice(&dev);
    (void)hipDeviceGetAttribute(&cus, hipDeviceAttributeMultiprocessorCount, dev);
    (void)hipFuncSetAttribute((const void*)mega, hipFuncAttributeMaxDynamicSharedMemorySize, LDS_BYTES);
    (void)hipOccupancyMaxActiveBlocksPerMultiprocessor(&per_cu, (const void*)mega, 512, LDS_BYTES);
    if (per_cu < 1) per_cu = 1;
    grid_blocks = cus * per_cu;
  }
  if (grid_blocks < 0) return;
  Params p{};
  const float** pp = (const float**)&p;
  for (int i = 0; i < 27; ++i) pp[i] = (const float*)d_in[i];
  p.out = (float*)d_out;
  p.ws = (unsigned char*)d_ws;
  void* args[] = {&p};
  hipError_t e = hipLaunchCooperativeKernel((const void*)mega, dim3(grid_blocks), dim3(512), args, LDS_BYTES, stream);
  if (e != hipSuccess) fprintf(stderr, "cooperative launch failed: %s (grid %d)\n", hipGetErrorString(e), grid_blocks);
}
```

```cpp
#include <hip/hip_runtime.h>
#include <hip/hip_cooperative_groups.h>
#include <cstdio>
namespace cg = cooperative_groups;

typedef unsigned short bf16_t;
typedef short bf16x8 __attribute__((ext_vector_type(8)));
typedef float f32x4 __attribute__((ext_vector_type(4)));
typedef float f32x2 __attribute__((ext_vector_type(2)));
typedef unsigned int u32;
typedef u32 u32x4 __attribute__((ext_vector_type(4)));
typedef u32 u32x2 __attribute__((ext_vector_type(2)));

#define DI __device__ __forceinline__

constexpr int T = 65536, S = 8192, D = 1024, NIN = 3456, NRW = 1920, DFF = 2816;
constexpr size_t MiB = 1ull << 20;
constexpr size_t O_WINT = 0, O_WOUTT = 7 * MiB, O_WUPT = 9 * MiB, O_WDOWNT = 20 * MiB;
constexpr size_t O_W2T = 26 * MiB, O_A2T = O_W2T + 131072, O_G2T = O_W2T + 262144;
constexpr size_t O_ROPE = 27 * MiB, O_RSTD1 = 29 * MiB, O_RSTD2 = O_RSTD1 + 262144, O_MISC = 30 * MiB;
constexpr size_t O_XB = 32 * MiB, O_LIN = 32 * MiB, O_YCAT = 32 * MiB, O_ACT = 32 * MiB;
constexpr size_t O_QK = 160 * MiB, O_VT = 288 * MiB, O_MIX = 160 * MiB;
constexpr size_t O_Z = 352 * MiB, O_E0 = 352 * MiB, O_E1 = 416 * MiB, O_A0 = 480 * MiB, O_A1 = 544 * MiB, O_GG = 608 * MiB;
constexpr size_t O_RS = 672 * MiB, O_KS = 736 * MiB, O_VS = 800 * MiB, O_KK = 864 * MiB;
constexpr size_t O_X1B = 416 * MiB, O_G = 544 * MiB, O_F = 544 * MiB;
constexpr size_t WS_END = 928 * MiB;

constexpr int LDS_BYTES = 131072;
constexpr float QSCALE = 0.125f * 1.4426950408889634f;

struct Params {
  const float *x, *pre_mix, *post_mix, *pre_ffn, *post_ffn, *w_in, *lq1, *lk1, *lq2, *lk2, *subln, *mu, *w0, *w2, *a0, *a2, *g2,
      *k_k, *k_a, *r_k, *gn_w, *gn_b, *w_out, *w_up, *conv_w, *conv_b, *w_down;
  float* out;
  unsigned char* ws;
};

typedef __bf16 bf16x2_t __attribute__((ext_vector_type(2)));
DI u32 pk2(float lo, float hi) {
  f32x2 f = {lo, hi};
  bf16x2_t b = __builtin_convertvector(f, bf16x2_t);
  return __builtin_bit_cast(u32, b);
}
DI bf16_t f2bf(float f) { return (bf16_t)(pk2(f, 0.f) & 0xffffu); }
DI float bf2f(u32 h) { return __uint_as_float(h << 16); }
DI float bflo(u32 w) { return __uint_as_float(w << 16); }
DI float bfhi(u32 w) { return __uint_as_float(w & 0xffff0000u); }
DI void st_bf4(bf16_t* p, f32x4 v) {
  u32x2 o;
  o.x = pk2(v[0], v[1]);
  o.y = pk2(v[2], v[3]);
  *(u32x2*)p = o;
}
DI float wave_sum(float v) {
#pragma unroll
  for (int o = 1; o < 64; o <<= 1) v += __shfl_xor(v, o);
  return v;
}
DI float sigmoidf_(float u) { return 1.f / (1.f + __expf(-u)); }
template <int CTRL>
DI float dppf(float v) {
  return __builtin_bit_cast(float, __builtin_amdgcn_update_dpp(0, __builtin_bit_cast(int, v), CTRL, 0xF, 0xF, true));
}
DI float row_sum16(float v) {
  v += dppf<0x128>(v);
  v += dppf<0x124>(v);
  v += dppf<0x122>(v);
  v += dppf<0x121>(v);
  return v;
}


DI void gsync(unsigned* bar, unsigned target) {
  __threadfence();
  __syncthreads();
  if (threadIdx.x == 0) {
    __hip_atomic_fetch_add(bar, 1u, __ATOMIC_RELEASE, __HIP_MEMORY_SCOPE_AGENT);
    while (__hip_atomic_load(bar, __ATOMIC_RELAXED, __HIP_MEMORY_SCOPE_AGENT) < target) __builtin_amdgcn_s_sleep(2);
  }
  __syncthreads();
  __builtin_amdgcn_fence(__ATOMIC_ACQUIRE, "agent");
}

typedef __attribute__((address_space(3))) unsigned int lds_u32;
DI void glds16(const void* g, unsigned char* l) {
  __builtin_amdgcn_global_load_lds((const unsigned*)g, (lds_u32*)l, 16, 0, 0);
}
#define WAIT_VM0() asm volatile("s_waitcnt vmcnt(0)" ::: "memory")
#define RAW_BAR() __builtin_amdgcn_s_barrier()

DI void gsync(unsigned* bar, int bid, int nb, unsigned k) {
  WAIT_VM0();
  __syncthreads();
  if (threadIdx.x == 0) {
    __builtin_amdgcn_fence(__ATOMIC_RELEASE, "agent");
    WAIT_VM0();
    if ((nb & 7) == 0) {
      const unsigned gsz = (unsigned)nb >> 3;
      const unsigned old = __hip_atomic_fetch_add(bar + 64 * (1 + (bid & 7)), 1u, __ATOMIC_RELAXED, __HIP_MEMORY_SCOPE_AGENT);
      if (old == gsz * k - 1u) __hip_atomic_fetch_add(bar, 1u, __ATOMIC_RELAXED, __HIP_MEMORY_SCOPE_AGENT);
      while (__hip_atomic_load(bar, __ATOMIC_RELAXED, __HIP_MEMORY_SCOPE_AGENT) < 8u * k) __builtin_amdgcn_s_sleep(1);
    } else {
      __hip_atomic_fetch_add(bar, 1u, __ATOMIC_RELAXED, __HIP_MEMORY_SCOPE_AGENT);
      while (__hip_atomic_load(bar, __ATOMIC_RELAXED, __HIP_MEMORY_SCOPE_AGENT) < (unsigned)nb * k) __builtin_amdgcn_s_sleep(1);
    }
    __builtin_amdgcn_fence(__ATOMIC_ACQUIRE, "agent");
    WAIT_VM0();
  }
  __syncthreads();
}

DI void transpose_job(const float* src, int K, int N, bf16_t* dst, const float* g, bool perm, float* tile, int bid, int nb, int tid) {
  const int nnt = N / 64, nit = (K / 64) * nnt;
  for (int it = bid; it < nit; it += nb) {
    const int kt = it / nnt, nt = it % nnt, k0 = kt * 64, n0 = nt * 64;
#pragma unroll
    for (int i = 0; i < 8; ++i) {
      const int kk = (tid >> 6) + 8 * i, nn = tid & 63;
      float v = src[(size_t)(k0 + kk) * N + n0 + nn];
      if (g) v *= g[k0 + kk];
      tile[kk * 65 + nn] = v;
    }
    __syncthreads();
#pragma unroll
    for (int i = 0; i < 8; ++i) {
      const int nn = (tid >> 6) + 8 * i, kk = tid & 63;
      const int n = n0 + nn;
      int nd = n;
      if (perm && n < 1024) {
        const int d = n & 63;
        nd = (n & ~63) | (2 * (d & 31) + (d >> 5));
      }
      dst[(size_t)nd * K + k0 + kk] = f2bf(tile[kk * 65 + nn]);
    }
    __syncthreads();
  }
}

constexpr int G_ASTAGE = 256 * 128, G_BSTAGE = 256 * 128, G_STAGE = G_ASTAGE + G_BSTAGE;

template <bool SWAP, class Epi>
DI void gemm_tile(const bf16_t* __restrict__ A, int lda, const bf16_t* __restrict__ Bt, int ldb, int K, int m0, int n0,
                  unsigned char* lds, const Epi& epi, int tid) {
  const int lane = tid & 63, wave = tid >> 6, wm = wave >> 2, wn = wave & 3, fr = lane & 15, fg = lane >> 4;
  f32x4 acc[8][4];
#pragma unroll
  for (int i = 0; i < 8; ++i)
#pragma unroll
    for (int j = 0; j < 4; ++j) acc[i][j] = (f32x4){0.f, 0.f, 0.f, 0.f};
  const int nk = K / 64;
  const int srow = tid >> 3, skc = tid & 7;
  const int gch = skc ^ ((srow >> 1) & 7);
  const int frs = (fr >> 1) & 7;
  const bf16_t* ga = A + (size_t)(m0 + srow) * lda + gch * 8;
  const bf16_t* gb = Bt + (size_t)(n0 + srow) * ldb + gch * 8;
  unsigned char* lw = lds + tid * 16;
#pragma unroll
  for (int i = 0; i < 4; ++i) glds16(ga + (size_t)(64 * i) * lda, lw + i * 8192);
#pragma unroll
  for (int i = 0; i < 4; ++i) glds16(gb + (size_t)(64 * i) * ldb, lw + G_ASTAGE + i * 8192);
  WAIT_VM0();
  RAW_BAR();
  const int aoff = (wm * 128 + fr) * 128, boff = G_ASTAGE + (wn * 64 + fr) * 128;
  const int c0 = ((0 * 4 + fg) ^ frs) * 16, c1 = ((1 * 4 + fg) ^ frs) * 16;
#define SB() __builtin_amdgcn_sched_barrier(0)
#define MMA16(AF, KS, MB)                                                                                                          \
  _Pragma("unroll") for (int mi = 0; mi < 4; ++mi) _Pragma("unroll") for (int ni = 0; ni < 4; ++ni) {                              \
    if (SWAP) acc[(MB) + mi][ni] = __builtin_amdgcn_mfma_f32_16x16x32_bf16(AF[mi], bfr[KS][ni], acc[(MB) + mi][ni], 0, 0, 0);     \
    else acc[(MB) + mi][ni] = __builtin_amdgcn_mfma_f32_16x16x32_bf16(bfr[KS][ni], AF[mi], acc[(MB) + mi][ni], 0, 0, 0);          \
  }
  for (int kt = 0; kt < nk; ++kt) {
    if (kt + 1 < nk) {
      unsigned char* l2 = lw + ((kt + 1) & 1) * G_STAGE;
#pragma unroll
      for (int i = 0; i < 4; ++i) glds16(ga + (size_t)(64 * i) * lda + (kt + 1) * 64, l2 + i * 8192);
#pragma unroll
      for (int i = 0; i < 4; ++i) glds16(gb + (size_t)(64 * i) * ldb + (kt + 1) * 64, l2 + G_ASTAGE + i * 8192);
    }
    const unsigned char* st = lds + (kt & 1) * G_STAGE;
    bf16x8 bfr[1][4], ax[4], ay[4];
#pragma unroll
    for (int i = 0; i < 4; ++i) bfr[0][i] = *(const bf16x8*)(st + boff + i * 2048 + c0);
#pragma unroll
    for (int i = 0; i < 4; ++i) ax[i] = *(const bf16x8*)(st + aoff + i * 2048 + c0);
    SB();
#pragma unroll
    for (int i = 0; i < 4; ++i) ay[i] = *(const bf16x8*)(st + aoff + (4 + i) * 2048 + c0);
    SB();
    MMA16(ax, 0, 0);
    SB();
#pragma unroll
    for (int i = 0; i < 4; ++i) ax[i] = *(const bf16x8*)(st + aoff + i * 2048 + c1);
    SB();
    MMA16(ay, 0, 4);
    SB();
#pragma unroll
    for (int i = 0; i < 4; ++i) bfr[0][i] = *(const bf16x8*)(st + boff + i * 2048 + c1);
#pragma unroll
    for (int i = 0; i < 4; ++i) ay[i] = *(const bf16x8*)(st + aoff + (4 + i) * 2048 + c1);
    SB();
    MMA16(ax, 0, 0);
    SB();
    MMA16(ay, 0, 4);
    WAIT_VM0();
    RAW_BAR();
  }
#undef MMA16
#undef SB
#pragma unroll
  for (int mi = 0; mi < 8; ++mi)
#pragma unroll
    for (int ni = 0; ni < 4; ++ni) {
      if (SWAP) epi(m0 + wm * 128 + mi * 16 + fg * 4, n0 + wn * 64 + ni * 16 + fr, acc[mi][ni]);
      else epi(m0 + wm * 128 + mi * 16 + fr, n0 + wn * 64 + ni * 16 + fg * 4, acc[mi][ni]);
      __builtin_amdgcn_sched_barrier(0);
    }
}

struct EpiInProj {
  const float* rstd; const f32x2* rope; bf16_t* qk; bf16_t* z;
  DI void operator()(int m, int n, f32x4 v) const {
    if (n >= NIN) return;
    const float rs = rstd[m];
    v = v * rs;
    if (n < 1024) {
      const int s = m & (S - 1), i = (n & 63) >> 1;
      const f32x2 c0 = rope[s * 32 + i], c1 = rope[s * 32 + i + 1];
      float a = v[0], b = v[1];
      v[0] = a * c0.x - b * c0.y; v[1] = b * c0.x + a * c0.y;
      a = v[2]; b = v[3];
      v[2] = a * c1.x - b * c1.y; v[3] = b * c1.x + a * c1.y;
      if (n < 512) v = v * QSCALE;
      st_bf4(qk + (size_t)m * 1024 + n, v);
    } else {
      st_bf4(z + (size_t)m * NRW + (n - 1536), v);
    }
  }
};
struct EpiV {
  const float* rstd; bf16_t* vt;
  DI void operator()(int m, int n, f32x4 v) const {
    const f32x4 rs = *(const f32x4*)(rstd + m);
    v = v * rs;
    const int nn = n - 1024, h = nn >> 7, vd = nn & 127, b = m >> 13, s = m & (S - 1);
    st_bf4(vt + ((size_t)((b * 4 + h) * 128 + vd)) * S + s, v);
  }
};
struct EpiLora {
  int mode; const float* bias; bf16_t* out;
  DI void operator()(int m, int n, f32x4 v) const {
    if (mode < 2) {
      const f32x4 bv = *(const f32x4*)(bias + n);
      const float sc = mode == 0 ? 0.60653065971f : 1.f;
#pragma unroll
      for (int j = 0; j < 4; ++j) v[j] = sc * sigmoidf_(v[j] + bv[j]);
    }
    st_bf4(out + (size_t)m * 512 + n, v);
  }
};
struct EpiF32 {
  float* out; int ld;
  DI void operator()(int m, int n, f32x4 v) const { *(f32x4*)(out + (size_t)m * ld + n) = v; }
};
struct EpiGate {
  const float* rstd; bf16_t* g;
  DI void operator()(int m, int n, f32x4 v) const { st_bf4(g + (size_t)m * DFF + n, v * rstd[m]); }
};
struct EpiUp {
  const float* rstd; const bf16_t* g; const float* cw; const float* cb; bf16_t* act;
  DI void operator()(int m, int n, f32x4 v) const {
    v = v * rstd[m];
    const int s = m & (S - 1);
    const bf16_t* gp = g + (size_t)m * DFF + n;
    const u32x2 g0 = *(const u32x2*)gp;
    u32x2 gm = (u32x2){0u, 0u}, gn = (u32x2){0u, 0u};
    if (s > 0) gm = *(const u32x2*)(gp - DFF);
    if (s < S - 1) gn = *(const u32x2*)(gp + DFF);
    const f32x4 w0 = *(const f32x4*)(cw + n), w1 = *(const f32x4*)(cw + DFF + n), w2 = *(const f32x4*)(cw + 2 * DFF + n), bb = *(const f32x4*)(cb + n);
    f32x4 c, p, q;
    c[0] = bflo(g0.x); c[1] = bfhi(g0.x); c[2] = bflo(g0.y); c[3] = bfhi(g0.y);
    p[0] = bflo(gm.x); p[1] = bfhi(gm.x); p[2] = bflo(gm.y); p[3] = bfhi(gm.y);
    q[0] = bflo(gn.x); q[1] = bfhi(gn.x); q[2] = bflo(gn.y); q[3] = bfhi(gn.y);
    f32x4 o;
#pragma unroll
    for (int j = 0; j < 4; ++j) {
      const float xg = w0[j] * p[j] + w1[j] * c[j] + w2[j] * q[j] + bb[j];
      const float y = 0.7978845608028654f * (xg + 0.044715f * xg * xg * xg);
      o[j] = xg / (1.f + __expf(-2.f * y)) * v[j];
    }
    st_bf4(act + (size_t)m * DFF + n, o);
  }
};

DI bool tile_of(int r, int bid, int nb, int w, int& mt, int& n) {
  if (nb == 256) {
    if (r >= w) return false;
    const int grp = bid & 7, j = bid >> 3, L = r * 32 + j, g = L / (w * 8), rem = L - g * w * 8;
    n = rem >> 3;
    mt = grp * 32 + g * 8 + (rem & 7);
    return true;
  }
  const int total = 256 * w, per = (total + nb - 1) / nb, it = bid * per + r;
  if (r >= per || it >= total) return false;
  mt = it / w;
  n = it % w;
  return true;
}
template <bool SWAP, class Epi>
DI void gemm_phase(const bf16_t* A, int lda, const bf16_t* Bt, int ldb, int K, int ntn, int nt_lo, int nt_hi, unsigned char* lds, const Epi& epi,
                   int bid, int nb, int tid) {
  const int w = nt_hi - nt_lo;
  for (int r = 0;; ++r) {
    int mt, n;
    if (!tile_of(r, bid, nb, w, mt, n)) break;
    gemm_tile<SWAP>(A, lda, Bt, ldb, K, mt * 256, (nt_lo + n) * 256, lds, epi, tid);
  }
}

DI void scan_chain(const Params& p, int chain, unsigned char* lds, int tid) {
  const int d = chain & 1, h = (chain >> 1) & 7, b = chain >> 4;
  float* rec = (float*)lds;
  float* ybuf = (float*)(lds + 98304);
  const bf16_t* RS = (const bf16_t*)(p.ws + O_RS);
  const bf16_t* KS = (const bf16_t*)(p.ws + O_KS);
  const bf16_t* VS = (const bf16_t*)(p.ws + O_VS);
  const bf16_t* KK = (const bf16_t*)(p.ws + O_KK);
  const bf16_t* EE = (const bf16_t*)(p.ws + (d ? O_E1 : O_E0));
  const bf16_t* AA = (const bf16_t*)(p.ws + (d ? O_A1 : O_A0));
  float* Y = p.out + (size_t)d * T * 512;
  const int lane = tid & 63, wave = tid >> 6, cgi = lane & 15, rg = lane >> 4, row0 = wave * 8 + rg * 2;
  const float ka = p.k_a[h * 64 + lane];
  float S0[4] = {0.f, 0.f, 0.f, 0.f}, S1[4] = {0.f, 0.f, 0.f, 0.f};
  bf16_t pr[4][6];
  const int ch = h * 64 + lane;
#define SCAN_TOK(n, k) ((size_t)(b * S + (d ? (S - 1 - ((n) * 32 + (k))) : ((n) * 32 + (k)))))
#define SCAN_LOAD(n)                                                      \
  _Pragma("unroll") for (int i = 0; i < 4; ++i) {                         \
    const size_t o_ = SCAN_TOK(n, wave + 8 * i) * 512 + ch;               \
    pr[i][0] = RS[o_]; pr[i][1] = KS[o_]; pr[i][2] = VS[o_];              \
    pr[i][3] = KK[o_]; pr[i][4] = EE[o_]; pr[i][5] = AA[o_];              \
  }
#define SCAN_XFORM(buf)                                                   \
  _Pragma("unroll") for (int i = 0; i < 4; ++i) {                         \
    float* R_ = rec + (buf) * 12288 + (wave + 8 * i) * 384 + lane;        \
    const float r_ = bf2f(pr[i][0]), k_ = bf2f(pr[i][1]), v_ = bf2f(pr[i][2]), kk_ = bf2f(pr[i][3]), e_ = bf2f(pr[i][4]), a_ = bf2f(pr[i][5]); \
    R_[0] = __expf(-e_); R_[64] = kk_; R_[128] = kk_ * a_; R_[192] = k_ * (1.f + (a_ - 1.f) * ka); R_[256] = r_; R_[320] = v_; \
  }
  SCAN_LOAD(0);
  SCAN_XFORM(0);
  __syncthreads();
  for (int n = 0; n < 256; ++n) {
    if (n + 1 < 256) { SCAN_LOAD(n + 1); }
    __builtin_amdgcn_sched_barrier(0);
    const float* RB = rec + (n & 1) * 12288;
    float* YB = ybuf + (n & 1) * 2048;
#pragma unroll 4
    for (int k = 0; k < 32; ++k) {
      const float* R = RB + k * 384;
      const f32x4 w4 = *(const f32x4*)(R + cgi * 4), kk4 = *(const f32x4*)(R + 64 + cgi * 4), b4 = *(const f32x4*)(R + 128 + cgi * 4),
                  kd4 = *(const f32x4*)(R + 192 + cgi * 4), r4 = *(const f32x4*)(R + 256 + cgi * 4);
      const f32x2 v2 = *(const f32x2*)(R + 320 + row0);
      float d0 = S0[0] * kk4[0] + S0[1] * kk4[1] + S0[2] * kk4[2] + S0[3] * kk4[3];
      float d1 = S1[0] * kk4[0] + S1[1] * kk4[1] + S1[2] * kk4[2] + S1[3] * kk4[3];
      d0 = row_sum16(d0);
      d1 = row_sum16(d1);
      float y0 = 0.f, y1 = 0.f;
#pragma unroll
      for (int c = 0; c < 4; ++c) {
        S0[c] = S0[c] * w4[c] + (v2.x * kd4[c] - d0 * b4[c]);
        S1[c] = S1[c] * w4[c] + (v2.y * kd4[c] - d1 * b4[c]);
        y0 += S0[c] * r4[c];
        y1 += S1[c] * r4[c];
      }
      y0 = row_sum16(y0);
      y1 = row_sum16(y1);
      if (cgi == 0) *(f32x2*)(YB + k * 64 + row0) = (f32x2){y0, y1};
    }
    if (n + 1 < 256) { SCAN_XFORM((n + 1) & 1); }
    __syncthreads();
    {
      const int k = tid >> 4, c4 = (tid & 15) * 4;
      *(f32x4*)(Y + SCAN_TOK(n, k) * 512 + h * 64 + c4) = *(const f32x4*)(YB + k * 64 + c4);
    }
  }
  __syncthreads();
#undef SCAN_TOK
#undef SCAN_LOAD
#undef SCAN_XFORM
}

constexpr int AT_K = 64 * 256, AT_V = 128 * 128, AT_STAGE = AT_K + AT_V;

DI void attn_item(const Params& p, int item, float lam, unsigned char* lds, int tid) {
  const int qb = item & 63, bh = item >> 6, h = bh & 3, b = bh >> 2;
  const int lane = tid & 63, wave = tid >> 6, fr = lane & 15, fg = lane >> 4;
  const bf16_t* QK = (const bf16_t*)(p.ws + O_QK);
  const bf16_t* VT = (const bf16_t*)(p.ws + O_VT);
  bf16_t* YC = (bf16_t*)(p.ws + O_YCAT);
  const int q0 = b * S + qb * 128 + wave * 16;
  bf16x8 qf[2][2];
#pragma unroll
  for (int c = 0; c < 2; ++c)
#pragma unroll
    for (int ks = 0; ks < 2; ++ks) qf[c][ks] = *(const bf16x8*)(QK + (size_t)(q0 + fr) * 1024 + h * 128 + c * 64 + ks * 32 + fg * 8);
  f32x4 o[2][8];
#pragma unroll
  for (int c = 0; c < 2; ++c)
#pragma unroll
    for (int i = 0; i < 8; ++i) o[c][i] = (f32x4){0.f, 0.f, 0.f, 0.f};
  float mrun[2] = {-1e30f, -1e30f}, lrun[2] = {0.f, 0.f};
  const int krow = tid >> 4, kkc = tid & 15;
  const int vrow = tid >> 3, vkc = tid & 7;
  const int kgc = kkc ^ ((((krow & 31) >> 3) << 2) | (krow & 3));
  const int vgc = vkc ^ ((vrow >> 1) & 7);
  const int krd = ((fr >> 2) * 8 + (fr & 3)) * 256;
  const int vrd = AT_K + fr * 128;
  const int frs = (fr >> 1) & 7;
  const bf16_t* gk = QK + (size_t)(b * S + krow) * 1024 + 512 + h * 128 + kgc * 8;
  const bf16_t* gv = VT + (size_t)((b * 4 + h) * 128 + vrow) * S + vgc * 8;
  unsigned char* lw = lds + tid * 16;
#pragma unroll
  for (int i = 0; i < 2; ++i) {
    glds16(gk + (size_t)(32 * i) * 1024, lw + i * 8192);
    glds16(gv + (size_t)(64 * i) * S, lw + AT_K + i * 8192);
  }
  WAIT_VM0();
  RAW_BAR();
  for (int kt = 0; kt < 128; ++kt) {
    if (kt + 1 < 128) {
      unsigned char* l2 = lw + ((kt + 1) & 1) * AT_STAGE;
#pragma unroll
      for (int i = 0; i < 2; ++i) {
        glds16(gk + (size_t)((kt + 1) * 64 + 32 * i) * 1024, l2 + i * 8192);
        glds16(gv + (size_t)(64 * i) * S + (kt + 1) * 64, l2 + AT_K + i * 8192);
      }
    }
    const unsigned char* sm = lds + (kt & 1) * AT_STAGE;
#define SB() __builtin_amdgcn_sched_barrier(0)
#define KFRAG(c, t4, ks) (*(const bf16x8*)(sm + krd + (((t4) >> 1) * 32 + ((t4) & 1) * 4) * 256 + ((((c) * 8 + (ks) * 4 + fg) ^ fr) * 16)))
#define VFRAG(vt, kb) (*(const bf16x8*)(sm + vrd + (vt) * 16 * 128 + ((((kb) * 4 + fg) ^ frs) * 16)))
    bf16x8 kf0[8], kf1[8];
#pragma unroll
    for (int i = 0; i < 8; ++i) kf0[i] = KFRAG(0, i >> 1, i & 1);
    SB();
#pragma unroll
    for (int i = 0; i < 8; ++i) kf1[i] = KFRAG(1, i >> 1, i & 1);
    SB();
    f32x4 s[2][4];
#pragma unroll
    for (int t4 = 0; t4 < 4; ++t4) {
      s[0][t4] = (f32x4){0.f, 0.f, 0.f, 0.f};
      s[0][t4] = __builtin_amdgcn_mfma_f32_16x16x32_bf16(kf0[t4 * 2], qf[0][0], s[0][t4], 0, 0, 0);
      s[0][t4] = __builtin_amdgcn_mfma_f32_16x16x32_bf16(kf0[t4 * 2 + 1], qf[0][1], s[0][t4], 0, 0, 0);
    }
    SB();
    bf16x8 va[4];
#pragma unroll
    for (int i = 0; i < 4; ++i) va[i] = VFRAG(i >> 1, i & 1);
    SB();
#pragma unroll
    for (int t4 = 0; t4 < 4; ++t4) {
      s[1][t4] = (f32x4){0.f, 0.f, 0.f, 0.f};
      s[1][t4] = __builtin_amdgcn_mfma_f32_16x16x32_bf16(kf1[t4 * 2], qf[1][0], s[1][t4], 0, 0, 0);
      s[1][t4] = __builtin_amdgcn_mfma_f32_16x16x32_bf16(kf1[t4 * 2 + 1], qf[1][1], s[1][t4], 0, 0, 0);
    }
    SB();
    float mx[2];
#pragma unroll
    for (int c = 0; c < 2; ++c) {
      mx[c] = fmaxf(fmaxf(s[c][0][0], s[c][0][1]), fmaxf(s[c][0][2], s[c][0][3]));
#pragma unroll
      for (int t4 = 1; t4 < 4; ++t4) mx[c] = fmaxf(mx[c], fmaxf(fmaxf(s[c][t4][0], s[c][t4][1]), fmaxf(s[c][t4][2], s[c][t4][3])));
    }
    if (__any((mx[0] > mrun[0] + 8.f) | (mx[1] > mrun[1] + 8.f))) {
#pragma unroll
      for (int c = 0; c < 2; ++c) {
        float m2 = fmaxf(mx[c], __shfl_xor(mx[c], 16));
        m2 = fmaxf(m2, __shfl_xor(m2, 32));
        const float mn = fmaxf(mrun[c], m2);
        const float alpha = __builtin_amdgcn_exp2f(mrun[c] - mn);
        mrun[c] = mn;
        lrun[c] *= alpha;
#pragma unroll
        for (int i = 0; i < 8; ++i) o[c][i] = o[c][i] * alpha;
      }
    }
    bf16x8 pf[2][2];
#pragma unroll
    for (int c = 0; c < 2; ++c) {
      const float mr = mrun[c];
      float ps = 0.f;
#pragma unroll
      for (int t4 = 0; t4 < 4; ++t4)
#pragma unroll
        for (int j = 0; j < 4; ++j) {
          s[c][t4][j] = __builtin_amdgcn_exp2f(s[c][t4][j] - mr);
          ps += s[c][t4][j];
        }
      lrun[c] += ps;
#pragma unroll
      for (int kb = 0; kb < 2; ++kb) {
        u32x4 w;
        w.x = pk2(s[c][2 * kb][0], s[c][2 * kb][1]);
        w.y = pk2(s[c][2 * kb][2], s[c][2 * kb][3]);
        w.z = pk2(s[c][2 * kb + 1][0], s[c][2 * kb + 1][1]);
        w.w = pk2(s[c][2 * kb + 1][2], s[c][2 * kb + 1][3]);
        pf[c][kb] = __builtin_bit_cast(bf16x8, w);
      }
    }
    SB();
#pragma unroll
    for (int g = 0; g < 4; ++g) {
      bf16x8 vb[4];
      if (g < 3) {
#pragma unroll
        for (int i = 0; i < 4; ++i) vb[i] = VFRAG(2 * g + 2 + (i >> 1), i & 1);
      }
      SB();
#pragma unroll
      for (int i = 0; i < 4; ++i) {
        o[0][2 * g + (i >> 1)] = __builtin_amdgcn_mfma_f32_16x16x32_bf16(va[i], pf[0][i & 1], o[0][2 * g + (i >> 1)], 0, 0, 0);
        o[1][2 * g + (i >> 1)] = __builtin_amdgcn_mfma_f32_16x16x32_bf16(va[i], pf[1][i & 1], o[1][2 * g + (i >> 1)], 0, 0, 0);
      }
      SB();
      if (g < 3) {
#pragma unroll
        for (int i = 0; i < 4; ++i) va[i] = vb[i];
      }
    }
#undef SB
#undef KFRAG
#undef VFRAG
    WAIT_VM0();
    RAW_BAR();
  }
  float l0 = lrun[0], l1 = lrun[1];
  l0 += __shfl_xor(l0, 16); l0 += __shfl_xor(l0, 32);
  l1 += __shfl_xor(l1, 16); l1 += __shfl_xor(l1, 32);
  const float i0 = 1.f / l0, i1 = lam / l1;
  float ss = 0.f;
#pragma unroll
  for (int vt = 0; vt < 8; ++vt) {
    o[0][vt] = o[0][vt] * i0 - o[1][vt] * i1;
#pragma unroll
    for (int j = 0; j < 4; ++j) ss += o[0][vt][j] * o[0][vt][j];
  }
  ss += __shfl_xor(ss, 16);
  ss += __shfl_xor(ss, 32);
  const float rs = rsqrtf(ss * (1.f / 128.f) + 1e-6f) * 0.8f;
#pragma unroll
  for (int vt = 0; vt < 8; ++vt) {
    const int vd = vt * 16 + fg * 4;
    const f32x4 g4 = *(const f32x4*)(p.subln + vd);
    st_bf4(YC + (size_t)(q0 + fr) * 1024 + h * 128 + vd, o[0][vt] * g4 * rs);
  }
}


#ifndef STOP
#define STOP 99
#endif
DI void digest(const Params& p, int which, int bid, int nb, int tid) {
  const unsigned char* ws = p.ws;
  for (size_t i = (size_t)bid * 512 + tid; i < (size_t)T * 1024; i += (size_t)nb * 512) {
    const size_t t = i >> 10; const int c = (int)(i & 1023);
    float v = 0.f;
    if (which == 3) {
      v = bf2f(((const bf16_t*)(ws + O_QK))[i]);
      if (c < 512) {
        const size_t o = t * 512 + c;
        v += bf2f(((const bf16_t*)(ws + O_VT))[o]) + bf2f(((const bf16_t*)(ws + O_RS))[o]) + bf2f(((const bf16_t*)(ws + O_KS))[o]) +
             bf2f(((const bf16_t*)(ws + O_VS))[o]) + bf2f(((const bf16_t*)(ws + O_KK))[o]) + bf2f(((const bf16_t*)(ws + O_E0))[o]) +
             bf2f(((const bf16_t*)(ws + O_E1))[o]) + bf2f(((const bf16_t*)(ws + O_A0))[o]) + bf2f(((const bf16_t*)(ws + O_A1))[o]) +
             bf2f(((const bf16_t*)(ws + O_GG))[o]);
      }
    } else if (which == 0) {
      v = bf2f(((const bf16_t*)(ws + O_XB))[i]) + ((const float*)(ws + O_RSTD1))[t] + bf2f(((const bf16_t*)(ws + O_WINT))[i % (size_t)(3456 * 1024)]) +
          bf2f(((const bf16_t*)(ws + O_WUPT))[i % (size_t)(5632 * 1024)]) + bf2f(((const bf16_t*)(ws + O_WDOWNT))[i % (size_t)(2816 * 1024)]) +
          bf2f(((const bf16_t*)(ws + O_WOUTT))[i % (size_t)(1024 * 1024)]) + bf2f(((const bf16_t*)(ws + O_W2T))[i % (size_t)(196608)]) +
          ((const float*)(ws + O_ROPE))[i % (size_t)(8192 * 64)];
    } else if (which == 1) {
      v = bf2f(((const bf16_t*)(ws + O_QK))[i]);
      if (c < 512) v += bf2f(((const bf16_t*)(ws + O_VT))[t * 512 + c]);
      v += bf2f(((const bf16_t*)(ws + O_Z))[t * 1920 + c]);
      if (c < 896) v += bf2f(((const bf16_t*)(ws + O_Z))[t * 1920 + 1024 + c]);
    } else if (which == 2) {
      if (c < 512) {
        const size_t o = t * 512 + c;
        v = bf2f(((const bf16_t*)(ws + O_RS))[o]) + bf2f(((const bf16_t*)(ws + O_KS))[o]) + bf2f(((const bf16_t*)(ws + O_VS))[o]) + bf2f(((const bf16_t*)(ws + O_KK))[o]);
      } else if (c < 896) v = bf2f(((const bf16_t*)(ws + O_LIN))[t * 384 + c - 512]);
    } else if (which == 6) {
      v = bf2f(((const bf16_t*)(ws + O_YCAT))[i]);
    }
    p.out[i] = v;
  }
}

__global__ void __launch_bounds__(512) mega(Params p) {
  cg::grid_group grid = cg::this_grid();
  extern __shared__ __attribute__((aligned(16))) unsigned char lds[];
  __shared__ int s_item;
  const int tid = threadIdx.x, bid = blockIdx.x, nb = gridDim.x, lane = tid & 63, wave = tid >> 6;
  const int gw = bid * 8 + wave, ngw = nb * 8;
  unsigned char* ws = p.ws;
  float* rstd1 = (float*)(ws + O_RSTD1);
  float* rstd2 = (float*)(ws + O_RSTD2);
  float* misc = (float*)(ws + O_MISC);
  unsigned* gbar = (unsigned*)(ws + O_MISC + 4096);

  {
    bf16_t* xb = (bf16_t*)(ws + O_XB);
    for (int row = gw; row < T; row += ngw) {
      const f32x4* xr = (const f32x4*)(p.x + (size_t)row * D) + lane;
      f32x4 v[4];
      float s = 0.f;
#pragma unroll
      for (int j = 0; j < 4; ++j) {
        v[j] = xr[64 * j];
        s += v[j][0] * v[j][0] + v[j][1] * v[j][1] + v[j][2] * v[j][2] + v[j][3] * v[j][3];
      }
      s = wave_sum(s);
      if (lane == 0) rstd1[row] = rsqrtf(s * (1.f / D) + 1e-6f);
      bf16_t* orow = xb + (size_t)row * D + lane * 4;
#pragma unroll
      for (int j = 0; j < 4; ++j) st_bf4(orow + 256 * j, v[j]);
    }
    float* tile = (float*)lds;
    transpose_job(p.w_in, D, NIN, (bf16_t*)(ws + O_WINT), p.pre_mix, true, tile, bid, nb, tid);
    transpose_job(p.w_out, D, D, (bf16_t*)(ws + O_WOUTT), nullptr, false, tile, bid, nb, tid);
    transpose_job(p.w_up, D, 2 * DFF, (bf16_t*)(ws + O_WUPT), p.pre_ffn, false, tile, bid, nb, tid);
    transpose_job(p.w_down, DFF, D, (bf16_t*)(ws + O_WDOWNT), nullptr, false, tile, bid, nb, tid);
    transpose_job(p.w2, 64, 512, (bf16_t*)(ws + O_W2T), nullptr, false, tile, bid, nb, tid);
    transpose_job(p.w2 + 64 * 512, 64, 512, (bf16_t*)(ws + O_W2T) + 512 * 64, nullptr, false, tile, bid, nb, tid);
    transpose_job(p.a2, 64, 512, (bf16_t*)(ws + O_A2T), nullptr, false, tile, bid, nb, tid);
    transpose_job(p.a2 + 64 * 512, 64, 512, (bf16_t*)(ws + O_A2T) + 512 * 64, nullptr, false, tile, bid, nb, tid);
    transpose_job(p.g2, 128, 512, (bf16_t*)(ws + O_G2T), nullptr, false, tile, bid, nb, tid);
    f32x2* rope = (f32x2*)(ws + O_ROPE);
    for (int i = bid * 512 + tid; i < S * 32; i += nb * 512) {
      const int s = i >> 5, f = i & 31;
      const float inv = powf(10000.f, -(float)f / 32.f);
      const float ang = (float)s * inv;
      rope[i] = (f32x2){cosf(ang), sinf(ang)};
    }
    if (bid == 0 && tid == 0) {
      float s1 = 0.f, s2 = 0.f;
      for (int i = 0; i < 64; ++i) {
        s1 += p.lq1[i] * p.lk1[i];
        s2 += p.lq2[i] * p.lk2[i];
      }
      misc[0] = expf(s1) - expf(s2) + 0.2f;
      for (int i = 0; i < 8; ++i) ((int*)misc)[16 + i * 16] = 0;
    }
  }
  grid.sync();
  if (STOP == 0) { digest(p, 0, bid, nb, tid); return; }

  {
    const bf16_t* xb = (const bf16_t*)(ws + O_XB);
    const bf16_t* wt = (const bf16_t*)(ws + O_WINT);
    EpiInProj e1{rstd1, (const f32x2*)(ws + O_ROPE), (bf16_t*)(ws + O_QK), (bf16_t*)(ws + O_Z)};
    EpiV ev{rstd1, (bf16_t*)(ws + O_VT)};
    for (int r = 0;; ++r) {
      int mt, nt;
      if (!tile_of(r, bid, nb, 14, mt, nt)) break;
      if (nt == 4 || nt == 5) gemm_tile<true>(xb, D, wt, D, D, mt * 256, nt * 256, lds, ev, tid);
      else gemm_tile<false>(xb, D, wt, D, D, mt * 256, nt * 256, lds, e1, tid);
    }
  }
  gsync(gbar, bid, nb, 1u);

  {
    const bf16_t* Z = (const bf16_t*)(ws + O_Z);
    bf16_t* RS = (bf16_t*)(ws + O_RS);
    bf16_t* KS = (bf16_t*)(ws + O_KS);
    bf16_t* VS = (bf16_t*)(ws + O_VS);
    bf16_t* KK = (bf16_t*)(ws + O_KK);
    bf16_t* LIN = (bf16_t*)(ws + O_LIN);
    for (int t = gw; t < T; t += ngw) {
      const int s = t & (S - 1);
      const bool hp = s > 0, hn = s < S - 1;
      const bf16_t* zc = Z + (size_t)t * NRW;
#pragma unroll 3
      for (int it = 0; it < 15; ++it) {
        const int c = it * 128 + lane * 2;
        const u32 z0 = *(const u32*)(zc + c);
        const u32 zp = hp ? *(const u32*)(zc + c - NRW) : 0u;
        const u32 zn = hn ? *(const u32*)(zc + c + NRW) : 0u;
        const f32x2 m = *(const f32x2*)(p.mu + c);
        const float a0 = bflo(z0), a1 = bfhi(z0);
        const float v0 = a0 + (0.5f * (bflo(zp) + bflo(zn)) - a0) * m.x;
        const float v1 = a1 + (0.5f * (bfhi(zp) + bfhi(zn)) - a1) * m.y;
        if (it < 4) {
          *(u32*)(RS + (size_t)t * 512 + c) = pk2(v0, v1);
        } else if (it < 8) {
          const int cc = c - 512;
          *(u32*)(KS + (size_t)t * 512 + cc) = pk2(v0, v1);
          const f32x2 kk = *(const f32x2*)(p.k_k + cc);
          const float f0 = v0 * kk.x, f1 = v1 * kk.y;
          float ss = f0 * f0 + f1 * f1;
#pragma unroll
          for (int o = 1; o < 32; o <<= 1) ss += __shfl_xor(ss, o);
          const float rn = rsqrtf(fmaxf(ss, 1e-12f));
          *(u32*)(KK + (size_t)t * 512 + cc) = pk2(f0 * rn, f1 * rn);
        } else if (it < 12) {
          *(u32*)(VS + (size_t)t * 512 + (c - 1024)) = pk2(v0, v1);
        } else if (it == 12) {
          *(u32*)(LIN + (size_t)t * 384 + (c - 1536)) = pk2(tanhf(v0), tanhf(v1));
        } else if (it == 13) {
          *(u32*)(LIN + (size_t)t * 384 + (c - 1536)) = pk2(v0, v1);
        } else {
          *(u32*)(LIN + (size_t)t * 384 + (c - 1536)) = pk2(sigmoidf_(v0), sigmoidf_(v1));
        }
      }
    }
  }
  gsync(gbar, bid, nb, 2u);
  if (STOP == 2) { digest(p, 2, bid, nb, tid); return; }

  {
    const bf16_t* LIN = (const bf16_t*)(ws + O_LIN);
    const bf16_t* W2T = (const bf16_t*)(ws + O_W2T);
    const bf16_t* A2T = (const bf16_t*)(ws + O_A2T);
    const bf16_t* G2T = (const bf16_t*)(ws + O_G2T);
#pragma unroll 1
    for (int job = 0; job < 5; ++job) {
      const int d = job & 1;
      const bf16_t* Aj = job < 2 ? LIN + d * 64 : (job < 4 ? LIN + 128 + d * 64 : LIN + 256);
      const bf16_t* Bj = job < 2 ? W2T + d * 512 * 64 : (job < 4 ? A2T + d * 512 * 64 : G2T);
      const int Kj = job < 4 ? 64 : 128;
      const size_t oo = job < 2 ? (d ? O_E1 : O_E0) : (job < 4 ? (d ? O_A1 : O_A0) : O_GG);
      EpiLora ej{job < 2 ? 0 : (job < 4 ? 1 : 2), job < 2 ? p.w0 + d * 512 : p.a0 + d * 512, (bf16_t*)(ws + oo)};
      gemm_phase<false>(Aj, 384, Bj, Kj, Kj, 2, 0, 2, lds, ej, bid, nb, tid);
    }
  }
  gsync(gbar, bid, nb, 3u);
  if (STOP == 3) { digest(p, 3, bid, nb, tid); return; }

  {
    const float lam = misc[0];
    const int grp = bid & 7;
    int* counter = (int*)misc + 16 + grp * 16;
    for (;;) {
      if (tid == 0) s_item = atomicAdd(counter, 1);
      __syncthreads();
      const int item = s_item;
      __syncthreads();
      if (item >= 16 + 256) break;
      if (item < 16) scan_chain(p, grp * 16 + item, lds, tid);
      else attn_item(p, grp * 256 + (item - 16), lam, lds, tid);
    }
  }
  gsync(gbar, bid, nb, 4u);

  {
    const float* Y0 = p.out;
    const float* Y1 = p.out + (size_t)T * 512;
    const bf16_t* RS = (const bf16_t*)(ws + O_RS);
    const bf16_t* KS = (const bf16_t*)(ws + O_KS);
    const bf16_t* VS = (const bf16_t*)(ws + O_VS);
    const bf16_t* A0 = (const bf16_t*)(ws + O_A0);
    const bf16_t* A1 = (const bf16_t*)(ws + O_A1);
    const bf16_t* GG = (const bf16_t*)(ws + O_GG);
    bf16_t* YC = (bf16_t*)(ws + O_YCAT);
    for (int idx = gw; idx < T * 8; idx += ngw) {
      const int t = idx >> 3, h = idx & 7, c = h * 64 + lane;
      const size_t o = (size_t)t * 512 + c;
      const float y = Y0[o] + Y1[o];
      const float mean = wave_sum(y) * (1.f / 64.f);
      const float dl = y - mean;
      const float var = wave_sum(dl * dl) * (1.f / 64.f);
      const float yn = dl * rsqrtf(var + 64e-5f) * p.gn_w[c] + p.gn_b[c];
      const float r = bf2f(RS[o]), k = bf2f(KS[o]), v = bf2f(VS[o]), a0 = bf2f(A0[o]), a1 = bf2f(A1[o]), g = bf2f(GG[o]);
      const float ka = p.k_a[c];
      const float kd = k * (2.f + (a0 + a1 - 2.f) * ka);
      const float bs = wave_sum(r * kd * p.r_k[c]);
      YC[(size_t)t * 1024 + 512 + c] = f2bf((yn + bs * v) * g);
    }
  }
  gsync(gbar, bid, nb, 5u);
  if (STOP == 6) { digest(p, 6, bid, nb, tid); return; }

  {
    EpiF32 e{(float*)(ws + O_MIX), D};
    gemm_phase<false>((const bf16_t*)(ws + O_YCAT), D, (const bf16_t*)(ws + O_WOUTT), D, D, 4, 0, 4, lds, e, bid, nb, tid);
  }
  gsync(gbar, bid, nb, 6u);

  {
    const float* mix = (const float*)(ws + O_MIX);
    bf16_t* x1b = (bf16_t*)(ws + O_X1B);
    for (int row = gw; row < T; row += ngw) {
      const f32x4* mr = (const f32x4*)(mix + (size_t)row * D) + lane;
      const f32x4* xr = (const f32x4*)(p.x + (size_t)row * D) + lane;
      const f32x4* gr = (const f32x4*)(p.post_mix) + lane;
      f32x4 mv[4];
      float s = 0.f;
#pragma unroll
      for (int j = 0; j < 4; ++j) {
        mv[j] = mr[64 * j];
        s += mv[j][0] * mv[j][0] + mv[j][1] * mv[j][1] + mv[j][2] * mv[j][2] + mv[j][3] * mv[j][3];
      }
      const float rs = rsqrtf(wave_sum(s) * (1.f / D) + 1e-6f);
      float s2 = 0.f;
      f32x4* orow = (f32x4*)(p.out + (size_t)row * D) + lane;
#pragma unroll
      for (int j = 0; j < 4; ++j) {
        mv[j] = xr[64 * j] + mv[j] * rs * gr[64 * j];
        s2 += mv[j][0] * mv[j][0] + mv[j][1] * mv[j][1] + mv[j][2] * mv[j][2] + mv[j][3] * mv[j][3];
        orow[64 * j] = mv[j];
        st_bf4(x1b + (size_t)row * D + lane * 4 + 256 * j, mv[j]);
      }
      s2 = wave_sum(s2);
      if (lane == 0) rstd2[row] = rsqrtf(s2 * (1.f / D) + 1e-6f);
    }
  }
  gsync(gbar, bid, nb, 7u);

  {
    EpiGate e{rstd2, (bf16_t*)(ws + O_G)};
    gemm_phase<false>((const bf16_t*)(ws + O_X1B), D, (const bf16_t*)(ws + O_WUPT), D, D, 11, 0, 11, lds, e, bid, nb, tid);
  }
  gsync(gbar, bid, nb, 8u);

  {
    EpiUp e{rstd2, (const bf16_t*)(ws + O_G), p.conv_w, p.conv_b, (bf16_t*)(ws + O_ACT)};
    gemm_phase<false>((const bf16_t*)(ws + O_X1B), D, (const bf16_t*)(ws + O_WUPT) + (size_t)DFF * D, D, D, 11, 0, 11, lds, e, bid, nb, tid);
  }
  gsync(gbar, bid, nb, 9u);

  {
    EpiF32 e{(float*)(ws + O_F), D};
    gemm_phase<false>((const bf16_t*)(ws + O_ACT), DFF, (const bf16_t*)(ws + O_WDOWNT), DFF, DFF, 4, 0, 4, lds, e, bid, nb, tid);
  }
  gsync(gbar, bid, nb, 10u);

  {
    const float* f = (const float*)(ws + O_F);
    for (int row = gw; row < T; row += ngw) {
      const f32x4* fr_ = (const f32x4*)(f + (size_t)row * D) + lane;
      const f32x4* gr = (const f32x4*)(p.post_ffn) + lane;
      f32x4* orow = (f32x4*)(p.out + (size_t)row * D) + lane;
      f32x4 fv[4];
      float s = 0.f;
#pragma unroll
      for (int j = 0; j < 4; ++j) {
        fv[j] = fr_[64 * j];
        s += fv[j][0] * fv[j][0] + fv[j][1] * fv[j][1] + fv[j][2] * fv[j][2] + fv[j][3] * fv[j][3];
      }
      const float rs = rsqrtf(wave_sum(s) * (1.f / D) + 1e-6f);
#pragma unroll
      for (int j = 0; j < 4; ++j) orow[64 * j] = orow[64 * j] + fv[j] * rs * gr[64 * j];
    }
  }
}

extern "C" void kernel_launch(void* const* d_in, const int* in_sizes, int n_in, void* d_out, int out_size, void* d_ws, size_t ws_size,
                              hipStream_t stream) {
  static int grid_blocks = 0;
  if (grid_blocks == 0) {
    if (n_in != 27 || in_sizes[0] != T * D || out_size != T * D || ws_size < WS_END) {
      fprintf(stderr, "kernel_launch: unexpected shapes (n_in %d, in0 %d, out %d, ws %zu)\n", n_in, n_in > 0 ? in_sizes[0] : -1, out_size, ws_size);
      grid_blocks = -1;
      return;
    }
    int dev = 0, cus = 0, per_cu = 0;
    (void)hipGetDevice(&dev);
    (void)hipDeviceGetAttribute(&cus, hipDeviceAttributeMultiprocessorCount, dev);
    (void)hipFuncSetAttribute((const void*)mega, hipFuncAttributeMaxDynamicSharedMemorySize, LDS_BYTES);
    (void)hipOccupancyMaxActiveBlocksPerMultiprocessor(&per_cu, (const void*)mega, 512, LDS_BYTES);
    if (per_cu < 1) per_cu = 1;
    grid_blocks = cus * per_cu;
  }
  if (grid_blocks < 0) return;
  Params p{};
  const float** pp = (const float**)&p;
  for (int i = 0; i < 27; ++i) pp[i] = (const float*)d_in[i];
  p.out = (float*)d_out;
  p.ws = (unsigned char*)d_ws;
  (void)hipMemsetAsync((char*)d_ws + O_MISC + 4096, 0, 4096, stream);
  void* args[] = {&p};
  hipError_t e = hipLaunchCooperativeKernel((const void*)mega, dim3(grid_blocks), dim3(512), args, LDS_BYTES, stream);
  if (e != hipSuccess) fprintf(stderr, "cooperative launch failed: %s (grid %d)\n", hipGetErrorString(e), grid_blocks);
}
```

```cpp
#include <hip/hip_runtime.h>
#include <hip/hip_cooperative_groups.h>
#include <cstdio>
namespace cg = cooperative_groups;

typedef unsigned short bf16_t;
typedef short bf16x8 __attribute__((ext_vector_type(8)));
typedef float f32x4 __attribute__((ext_vector_type(4)));
typedef float f32x2 __attribute__((ext_vector_type(2)));
typedef unsigned int u32;
typedef u32 u32x4 __attribute__((ext_vector_type(4)));
typedef u32 u32x2 __attribute__((ext_vector_type(2)));

#define DI __device__ __forceinline__

constexpr int T = 65536, S = 8192, D = 1024, NIN = 3456, NRW = 1920, DFF = 2816;
constexpr size_t MiB = 1ull << 20;
constexpr size_t O_WINT = 0, O_WOUTT = 7 * MiB, O_WUPT = 9 * MiB, O_WDOWNT = 20 * MiB;
constexpr size_t O_W2T = 26 * MiB, O_A2T = O_W2T + 131072, O_G2T = O_W2T + 262144;
constexpr size_t O_ROPE = 27 * MiB, O_RSTD1 = 29 * MiB, O_RSTD2 = O_RSTD1 + 262144, O_MISC = 30 * MiB;
constexpr size_t O_XB = 32 * MiB, O_LIN = 32 * MiB, O_YCAT = 32 * MiB, O_ACT = 32 * MiB;
constexpr size_t O_QK = 160 * MiB, O_VT = 288 * MiB, O_MIX = 160 * MiB;
constexpr size_t O_Z = 352 * MiB, O_E0 = 352 * MiB, O_E1 = 416 * MiB, O_A0 = 480 * MiB, O_A1 = 544 * MiB, O_GG = 608 * MiB;
constexpr size_t O_RS = 672 * MiB, O_KS = 736 * MiB, O_VS = 800 * MiB, O_KK = 864 * MiB;
constexpr size_t O_X1B = 416 * MiB, O_G = 544 * MiB, O_F = 544 * MiB;
constexpr size_t WS_END = 928 * MiB;

constexpr int LDS_BYTES = 131072;
constexpr float QSCALE = 0.125f * 1.4426950408889634f;

struct Params {
  const float *x, *pre_mix, *post_mix, *pre_ffn, *post_ffn, *w_in, *lq1, *lk1, *lq2, *lk2, *subln, *mu, *w0, *w2, *a0, *a2, *g2,
      *k_k, *k_a, *r_k, *gn_w, *gn_b, *w_out, *w_up, *conv_w, *conv_b, *w_down;
  float* out;
  unsigned char* ws;
};

typedef __bf16 bf16x2_t __attribute__((ext_vector_type(2)));
DI u32 pk2(float lo, float hi) {
  f32x2 f = {lo, hi};
  bf16x2_t b = __builtin_convertvector(f, bf16x2_t);
  return __builtin_bit_cast(u32, b);
}
DI bf16_t f2bf(float f) { return (bf16_t)(pk2(f, 0.f) & 0xffffu); }
DI float bf2f(u32 h) { return __uint_as_float(h << 16); }
DI float bflo(u32 w) { return __uint_as_float(w << 16); }
DI float bfhi(u32 w) { return __uint_as_float(w & 0xffff0000u); }
DI void st_bf4(bf16_t* p, f32x4 v) {
  u32x2 o;
  o.x = pk2(v[0], v[1]);
  o.y = pk2(v[2], v[3]);
  *(u32x2*)p = o;
}
DI float wave_sum(float v) {
#pragma unroll
  for (int o = 1; o < 64; o <<= 1) v += __shfl_xor(v, o);
  return v;
}
DI float sigmoidf_(float u) { return 1.f / (1.f + __expf(-u)); }
template <int CTRL>
DI float dppf(float v) {
  return __builtin_bit_cast(float, __builtin_amdgcn_update_dpp(0, __builtin_bit_cast(int, v), CTRL, 0xF, 0xF, true));
}
DI float row_sum16(float v) {
  v += dppf<0x128>(v);
  v += dppf<0x124>(v);
  v += dppf<0x122>(v);
  v += dppf<0x121>(v);
  return v;
}


DI void gsync(unsigned* bar, unsigned target) {
  __threadfence();
  __syncthreads();
  if (threadIdx.x == 0) {
    __hip_atomic_fetch_add(bar, 1u, __ATOMIC_RELEASE, __HIP_MEMORY_SCOPE_AGENT);
    while (__hip_atomic_load(bar, __ATOMIC_RELAXED, __HIP_MEMORY_SCOPE_AGENT) < target) __builtin_amdgcn_s_sleep(2);
  }
  __syncthreads();
  __builtin_amdgcn_fence(__ATOMIC_ACQUIRE, "agent");
}

typedef __attribute__((address_space(3))) unsigned int lds_u32;
DI void glds16(const void* g, unsigned char* l) {
  __builtin_amdgcn_global_load_lds((const unsigned*)g, (lds_u32*)l, 16, 0, 0);
}
#define WAIT_VM0() asm volatile("s_waitcnt vmcnt(0)" ::: "memory")
#define RAW_BAR() __builtin_amdgcn_s_barrier()

DI void gsync(unsigned* bar, int bid, int nb, unsigned k) {
  WAIT_VM0();
  __syncthreads();
  if (threadIdx.x == 0) {
    __builtin_amdgcn_fence(__ATOMIC_RELEASE, "agent");
    WAIT_VM0();
    if ((nb & 7) == 0) {
      const unsigned gsz = (unsigned)nb >> 3;
      const unsigned old = __hip_atomic_fetch_add(bar + 64 * (1 + (bid & 7)), 1u, __ATOMIC_RELAXED, __HIP_MEMORY_SCOPE_AGENT);
      if (old == gsz * k - 1u) __hip_atomic_fetch_add(bar, 1u, __ATOMIC_RELAXED, __HIP_MEMORY_SCOPE_AGENT);
      while (__hip_atomic_load(bar, __ATOMIC_RELAXED, __HIP_MEMORY_SCOPE_AGENT) < 8u * k) __builtin_amdgcn_s_sleep(1);
    } else {
      __hip_atomic_fetch_add(bar, 1u, __ATOMIC_RELAXED, __HIP_MEMORY_SCOPE_AGENT);
      while (__hip_atomic_load(bar, __ATOMIC_RELAXED, __HIP_MEMORY_SCOPE_AGENT) < (unsigned)nb * k) __builtin_amdgcn_s_sleep(1);
    }
    __builtin_amdgcn_fence(__ATOMIC_ACQUIRE, "agent");
    WAIT_VM0();
  }
  __syncthreads();
}

DI void transpose_job(const float* src, int K, int N, bf16_t* dst, const float* g, bool perm, float* tile, int bid, int nb, int tid) {
  const int nnt = N / 64, nit = (K / 64) * nnt;
  for (int it = bid; it < nit; it += nb) {
    const int kt = it / nnt, nt = it % nnt, k0 = kt * 64, n0 = nt * 64;
#pragma unroll
    for (int i = 0; i < 8; ++i) {
      const int kk = (tid >> 6) + 8 * i, nn = tid & 63;
      float v = src[(size_t)(k0 + kk) * N + n0 + nn];
      if (g) v *= g[k0 + kk];
      tile[kk * 65 + nn] = v;
    }
    __syncthreads();
#pragma unroll
    for (int i = 0; i < 8; ++i) {
      const int nn = (tid >> 6) + 8 * i, kk = tid & 63;
      const int n = n0 + nn;
      int nd = n;
      if (perm && n < 1024) {
        const int d = n & 63;
        nd = (n & ~63) | (2 * (d & 31) + (d >> 5));
      }
      dst[(size_t)nd * K + k0 + kk] = f2bf(tile[kk * 65 + nn]);
    }
    __syncthreads();
  }
}

constexpr int G_ASTAGE = 256 * 128, G_BSTAGE = 256 * 128, G_STAGE = G_ASTAGE + G_BSTAGE;

template <bool SWAP, class Epi>
DI void gemm_tile(const bf16_t* __restrict__ A, int lda, const bf16_t* __restrict__ Bt, int ldb, int K, int m0, int n0,
                  unsigned char* lds, const Epi& epi, int tid) {
  const int lane = tid & 63, wave = tid >> 6, wm = wave >> 2, wn = wave & 3, fr = lane & 15, fg = lane >> 4;
  f32x4 acc[8][4];
#pragma unroll
  for (int i = 0; i < 8; ++i)
#pragma unroll
    for (int j = 0; j < 4; ++j) acc[i][j] = (f32x4){0.f, 0.f, 0.f, 0.f};
  const int nk = K / 64;
  const int srow = tid >> 3, skc = tid & 7;
  const int gch = skc ^ ((srow >> 1) & 7);
  const int frs = (fr >> 1) & 7;
  const bf16_t* ga = A + (size_t)(m0 + srow) * lda + gch * 8;
  const bf16_t* gb = Bt + (size_t)(n0 + srow) * ldb + gch * 8;
  unsigned char* lw = lds + tid * 16;
#pragma unroll
  for (int i = 0; i < 4; ++i) glds16(ga + (size_t)(64 * i) * lda, lw + i * 8192);
#pragma unroll
  for (int i = 0; i < 4; ++i) glds16(gb + (size_t)(64 * i) * ldb, lw + G_ASTAGE + i * 8192);
  WAIT_VM0();
  RAW_BAR();
  const int aoff = (wm * 128 + fr) * 128, boff = G_ASTAGE + (wn * 64 + fr) * 128;
  const int c0 = ((0 * 4 + fg) ^ frs) * 16, c1 = ((1 * 4 + fg) ^ frs) * 16;
#define SB() __builtin_amdgcn_sched_barrier(0)
#define MMA16(AF, KS, MB)                                                                                                          \
  _Pragma("unroll") for (int mi = 0; mi < 4; ++mi) _Pragma("unroll") for (int ni = 0; ni < 4; ++ni) {                              \
    if (SWAP) acc[(MB) + mi][ni] = __builtin_amdgcn_mfma_f32_16x16x32_bf16(AF[mi], bfr[KS][ni], acc[(MB) + mi][ni], 0, 0, 0);     \
    else acc[(MB) + mi][ni] = __builtin_amdgcn_mfma_f32_16x16x32_bf16(bfr[KS][ni], AF[mi], acc[(MB) + mi][ni], 0, 0, 0);          \
  }
  for (int kt = 0; kt < nk; ++kt) {
    if (kt + 1 < nk) {
      unsigned char* l2 = lw + ((kt + 1) & 1) * G_STAGE;
#pragma unroll
      for (int i = 0; i < 4; ++i) glds16(ga + (size_t)(64 * i) * lda + (kt + 1) * 64, l2 + i * 8192);
#pragma unroll
      for (int i = 0; i < 4; ++i) glds16(gb + (size_t)(64 * i) * ldb + (kt + 1) * 64, l2 + G_ASTAGE + i * 8192);
    }
    const unsigned char* st = lds + (kt & 1) * G_STAGE;
    bf16x8 bfr[1][4], ax[4], ay[4];
#pragma unroll
    for (int i = 0; i < 4; ++i) bfr[0][i] = *(const bf16x8*)(st + boff + i * 2048 + c0);
#pragma unroll
    for (int i = 0; i < 4; ++i) ax[i] = *(const bf16x8*)(st + aoff + i * 2048 + c0);
    SB();
#pragma unroll
    for (int i = 0; i < 4; ++i) ay[i] = *(const bf16x8*)(st + aoff + (4 + i) * 2048 + c0);
    SB();
    MMA16(ax, 0, 0);
    SB();
#pragma unroll
    for (int i = 0; i < 4; ++i) ax[i] = *(const bf16x8*)(st + aoff + i * 2048 + c1);
    SB();
    MMA16(ay, 0, 4);
    SB();
#pragma unroll
    for (int i = 0; i < 4; ++i) bfr[0][i] = *(const bf16x8*)(st + boff + i * 2048 + c1);
#pragma unroll
    for (int i = 0; i < 4; ++i) ay[i] = *(const bf16x8*)(st + aoff + (4 + i) * 2048 + c1);
    SB();
    MMA16(ax, 0, 0);
    SB();
    MMA16(ay, 0, 4);
    WAIT_VM0();
    RAW_BAR();
  }
#undef MMA16
#undef SB
#pragma unroll
  for (int mi = 0; mi < 8; ++mi)
#pragma unroll
    for (int ni = 0; ni < 4; ++ni) {
      if (SWAP) epi(m0 + wm * 128 + mi * 16 + fg * 4, n0 + wn * 64 + ni * 16 + fr, acc[mi][ni]);
      else epi(m0 + wm * 128 + mi * 16 + fr, n0 + wn * 64 + ni * 16 + fg * 4, acc[mi][ni]);
      __builtin_amdgcn_sched_barrier(0);
    }
}

struct EpiInProj {
  const float* rstd; const f32x2* rope; bf16_t* qk; bf16_t* z;
  DI void operator()(int m, int n, f32x4 v) const {
    if (n >= NIN) return;
    const float rs = rstd[m];
    v = v * rs;
    if (n < 1024) {
      const int s = m & (S - 1), i = (n & 63) >> 1;
      const f32x2 c0 = rope[s * 32 + i], c1 = rope[s * 32 + i + 1];
      float a = v[0], b = v[1];
      v[0] = a * c0.x - b * c0.y; v[1] = b * c0.x + a * c0.y;
      a = v[2]; b = v[3];
      v[2] = a * c1.x - b * c1.y; v[3] = b * c1.x + a * c1.y;
      if (n < 512) v = v * QSCALE;
      st_bf4(qk + (size_t)m * 1024 + n, v);
    } else {
      st_bf4(z + (size_t)m * NRW + (n - 1536), v);
    }
  }
};
struct EpiV {
  const float* rstd; bf16_t* vt;
  DI void operator()(int m, int n, f32x4 v) const {
    const f32x4 rs = *(const f32x4*)(rstd + m);
    v = v * rs;
    const int nn = n - 1024, h = nn >> 7, vd = nn & 127, b = m >> 13, s = m & (S - 1);
    st_bf4(vt + ((size_t)((b * 4 + h) * 128 + vd)) * S + s, v);
  }
};
struct EpiLora {
  int mode; const float* bias; bf16_t* out;
  DI void operator()(int m, int n, f32x4 v) const {
    if (mode < 2) {
      const f32x4 bv = *(const f32x4*)(bias + n);
      const float sc = mode == 0 ? 0.60653065971f : 1.f;
#pragma unroll
      for (int j = 0; j < 4; ++j) v[j] = sc * sigmoidf_(v[j] + bv[j]);
    }
    st_bf4(out + (size_t)m * 512 + n, v);
  }
};
struct EpiB16 {
  bf16_t* out; int ld;
  DI void operator()(int m, int n, f32x4 v) const { st_bf4(out + (size_t)m * ld + n, v); }
};
struct EpiF32 {
  float* out; int ld;
  DI void operator()(int m, int n, f32x4 v) const { *(f32x4*)(out + (size_t)m * ld + n) = v; }
};
struct EpiGate {
  const float* rstd; bf16_t* g;
  DI void operator()(int m, int n, f32x4 v) const { st_bf4(g + (size_t)m * DFF + n, v * rstd[m]); }
};
struct EpiUp {
  const float* rstd; const bf16_t* g; const float* cw; const float* cb; bf16_t* act;
  DI void operator()(int m, int n, f32x4 v) const {
    v = v * rstd[m];
    const int s = m & (S - 1);
    const bf16_t* gp = g + (size_t)m * DFF + n;
    const u32x2 g0 = *(const u32x2*)gp;
    u32x2 gm = (u32x2){0u, 0u}, gn = (u32x2){0u, 0u};
    if (s > 0) gm = *(const u32x2*)(gp - DFF);
    if (s < S - 1) gn = *(const u32x2*)(gp + DFF);
    const f32x4 w0 = *(const f32x4*)(cw + n), w1 = *(const f32x4*)(cw + DFF + n), w2 = *(const f32x4*)(cw + 2 * DFF + n), bb = *(const f32x4*)(cb + n);
    f32x4 c, p, q;
    c[0] = bflo(g0.x); c[1] = bfhi(g0.x); c[2] = bflo(g0.y); c[3] = bfhi(g0.y);
    p[0] = bflo(gm.x); p[1] = bfhi(gm.x); p[2] = bflo(gm.y); p[3] = bfhi(gm.y);
    q[0] = bflo(gn.x); q[1] = bfhi(gn.x); q[2] = bflo(gn.y); q[3] = bfhi(gn.y);
    f32x4 o;
#pragma unroll
    for (int j = 0; j < 4; ++j) {
      const float xg = w0[j] * p[j] + w1[j] * c[j] + w2[j] * q[j] + bb[j];
      const float y = 0.7978845608028654f * (xg + 0.044715f * xg * xg * xg);
      o[j] = xg / (1.f + __expf(-2.f * y)) * v[j];
    }
    st_bf4(act + (size_t)m * DFF + n, o);
  }
};

DI bool tile_of(int r, int bid, int nb, int w, int& mt, int& n) {
  if (nb == 256) {
    if (r >= w) return false;
    const int grp = bid & 7, j = bid >> 3, L = r * 32 + j, g = L / (w * 8), rem = L - g * w * 8;
    n = rem >> 3;
    mt = grp * 32 + g * 8 + (rem & 7);
    return true;
  }
  const int total = 256 * w, per = (total + nb - 1) / nb, it = bid * per + r;
  if (r >= per || it >= total) return false;
  mt = it / w;
  n = it % w;
  return true;
}
template <bool SWAP, class Epi>
DI void gemm_phase(const bf16_t* A, int lda, const bf16_t* Bt, int ldb, int K, int ntn, int nt_lo, int nt_hi, unsigned char* lds, const Epi& epi,
                   int bid, int nb, int tid) {
  const int w = nt_hi - nt_lo;
  for (int r = 0;; ++r) {
    int mt, n;
    if (!tile_of(r, bid, nb, w, mt, n)) break;
    gemm_tile<SWAP>(A, lda, Bt, ldb, K, mt * 256, (nt_lo + n) * 256, lds, epi, tid);
  }
}

DI float row_sum8(float v) {
  v += dppf<0x141>(v);
  v += dppf<0xB1>(v);
  v += dppf<0x4E>(v);
  return v;
}
DI void scan_chain(const Params& p, int chain, unsigned char* lds, int tid) {
  const int d = chain & 1, h = (chain >> 1) & 7, b = chain >> 4;
  float* rec = (float*)lds;
  float* ybuf = (float*)(lds + 98304);
  const bf16_t* RS = (const bf16_t*)(p.ws + O_RS);
  const bf16_t* KS = (const bf16_t*)(p.ws + O_KS);
  const bf16_t* VS = (const bf16_t*)(p.ws + O_VS);
  const bf16_t* KK = (const bf16_t*)(p.ws + O_KK);
  const bf16_t* EE = (const bf16_t*)(p.ws + (d ? O_E1 : O_E0));
  const bf16_t* AA = (const bf16_t*)(p.ws + (d ? O_A1 : O_A0));
  float* Y = p.out + (size_t)d * T * 512;
  const int lane = tid & 63, wave = tid >> 6, cg = lane & 7, rg = lane >> 3, row = wave * 8 + rg;
  const float ka = p.k_a[h * 64 + lane];
  float St[8];
#pragma unroll
  for (int c = 0; c < 8; ++c) St[c] = 0.f;
  bf16_t pr[4][6];
  const int ch = h * 64 + lane;
#define SCAN_TOK(n, k) ((size_t)(b * S + (d ? (S - 1 - ((n) * 32 + (k))) : ((n) * 32 + (k)))))
#define SCAN_LOAD(n)                                                      \
  _Pragma("unroll") for (int i = 0; i < 4; ++i) {                         \
    const size_t o_ = SCAN_TOK(n, wave + 8 * i) * 512 + ch;               \
    pr[i][0] = RS[o_]; pr[i][1] = KS[o_]; pr[i][2] = VS[o_];              \
    pr[i][3] = KK[o_]; pr[i][4] = EE[o_]; pr[i][5] = AA[o_];              \
  }
#define SCAN_XFORM(buf)                                                   \
  _Pragma("unroll") for (int i = 0; i < 4; ++i) {                         \
    float* R_ = rec + (buf) * 12288 + (wave + 8 * i) * 384 + lane;        \
    const float r_ = bf2f(pr[i][0]), k_ = bf2f(pr[i][1]), v_ = bf2f(pr[i][2]), kk_ = bf2f(pr[i][3]), e_ = bf2f(pr[i][4]), a_ = bf2f(pr[i][5]); \
    R_[0] = __expf(-e_); R_[64] = kk_; R_[128] = kk_ * a_; R_[192] = k_ * (1.f + (a_ - 1.f) * ka); R_[256] = r_; R_[320] = v_; \
  }
  SCAN_LOAD(0);
  SCAN_XFORM(0);
  __syncthreads();
  for (int n = 0; n < 256; ++n) {
    if (n + 1 < 256) { SCAN_LOAD(n + 1); }
    __builtin_amdgcn_sched_barrier(0);
    const float* RB = rec + (n & 1) * 12288;
    float* YB = ybuf + (n & 1) * 2048;
#define OPS_LOAD(P, k)                                                                                              \
  {                                                                                                                 \
    const float* R_ = RB + (k) * 384 + cg * 8;                                                                      \
    P##wa = *(const f32x4*)(R_); P##wb = *(const f32x4*)(R_ + 4);                                                   \
    P##ka = *(const f32x4*)(R_ + 64); P##kb = *(const f32x4*)(R_ + 68);                                             \
    P##ba = *(const f32x4*)(R_ + 128); P##bb = *(const f32x4*)(R_ + 132);                                           \
    P##da = *(const f32x4*)(R_ + 192); P##db = *(const f32x4*)(R_ + 196);                                           \
    P##ra = *(const f32x4*)(R_ + 256); P##rb = *(const f32x4*)(R_ + 260);                                           \
    P##v = RB[(k) * 384 + 320 + row];                                                                               \
  }
#define STEP(P, k)                                                                                                  \
  {                                                                                                                 \
    float d0 = 0.f, d1 = 0.f;                                                                                       \
    _Pragma("unroll") for (int c = 0; c < 4; ++c) { d0 += St[c] * P##ka[c]; d1 += St[c + 4] * P##kb[c]; }           \
    const float dt = row_sum8(d0 + d1);                                                                             \
    float y0 = 0.f, y1 = 0.f;                                                                                       \
    _Pragma("unroll") for (int c = 0; c < 4; ++c) {                                                                 \
      St[c] = St[c] * P##wa[c] + (P##v * P##da[c] - dt * P##ba[c]);                                                 \
      St[c + 4] = St[c + 4] * P##wb[c] + (P##v * P##db[c] - dt * P##bb[c]);                                         \
      y0 += St[c] * P##ra[c];                                                                                       \
      y1 += St[c + 4] * P##rb[c];                                                                                   \
    }                                                                                                               \
    const float yy = row_sum8(y0 + y1);                                                                             \
    if (cg == 0) YB[(k) * 64 + row] = yy;                                                                           \
  }
    f32x4 Awa, Awb, Aka, Akb, Aba, Abb, Ada, Adb, Ara, Arb, Bwa, Bwb, Bka, Bkb, Bba, Bbb, Bda, Bdb, Bra, Brb;
    float Av, Bv;
    OPS_LOAD(A, 0);
#pragma unroll 2
    for (int k = 0; k < 32; k += 2) {
      OPS_LOAD(B, k + 1);
      __builtin_amdgcn_sched_barrier(0);
      STEP(A, k);
      __builtin_amdgcn_sched_barrier(0);
      if (k + 2 < 32) OPS_LOAD(A, k + 2);
      __builtin_amdgcn_sched_barrier(0);
      STEP(B, k + 1);
      __builtin_amdgcn_sched_barrier(0);
    }
#undef OPS_LOAD
#undef STEP
    if (n + 1 < 256) { SCAN_XFORM((n + 1) & 1); }
    __syncthreads();
    {
      const int k = tid >> 4, c4 = (tid & 15) * 4;
      *(f32x4*)(Y + SCAN_TOK(n, k) * 512 + h * 64 + c4) = *(const f32x4*)(YB + k * 64 + c4);
    }
  }
  __syncthreads();
#undef SCAN_TOK
#undef SCAN_LOAD
#undef SCAN_XFORM
}

constexpr int AT_K = 64 * 256, AT_V = 128 * 128, AT_STAGE = AT_K + AT_V;

DI void attn_item(const Params& p, int item, float lam, unsigned char* lds, int tid) {
  const int qb = item & 63, bh = item >> 6, h = bh & 3, b = bh >> 2;
  const int lane = tid & 63, wave = tid >> 6, fr = lane & 15, fg = lane >> 4;
  const bf16_t* QK = (const bf16_t*)(p.ws + O_QK);
  const bf16_t* VT = (const bf16_t*)(p.ws + O_VT);
  bf16_t* YC = (bf16_t*)(p.ws + O_YCAT);
  const int q0 = b * S + qb * 128 + wave * 16;
  bf16x8 qf[2][2];
#pragma unroll
  for (int c = 0; c < 2; ++c)
#pragma unroll
    for (int ks = 0; ks < 2; ++ks) qf[c][ks] = *(const bf16x8*)(QK + (size_t)(q0 + fr) * 1024 + h * 128 + c * 64 + ks * 32 + fg * 8);
  f32x4 o[2][8];
#pragma unroll
  for (int c = 0; c < 2; ++c)
#pragma unroll
    for (int i = 0; i < 8; ++i) o[c][i] = (f32x4){0.f, 0.f, 0.f, 0.f};
  float mrun[2] = {-1e30f, -1e30f}, lrun[2] = {0.f, 0.f};
  const int krow = tid >> 4, kkc = tid & 15;
  const int vrow = tid >> 3, vkc = tid & 7;
  const int kgc = kkc ^ ((((krow & 31) >> 3) << 2) | (krow & 3));
  const int vgc = vkc ^ ((vrow >> 1) & 7);
  const int krd = ((fr >> 2) * 8 + (fr & 3)) * 256;
  const int vrd = AT_K + fr * 128;
  const int frs = (fr >> 1) & 7;
  const bf16_t* gk = QK + (size_t)(b * S + krow) * 1024 + 512 + h * 128 + kgc * 8;
  const bf16_t* gv = VT + (size_t)((b * 4 + h) * 128 + vrow) * S + vgc * 8;
  unsigned char* lw = lds + tid * 16;
#pragma unroll
  for (int i = 0; i < 2; ++i) {
    glds16(gk + (size_t)(32 * i) * 1024, lw + i * 8192);
    glds16(gv + (size_t)(64 * i) * S, lw + AT_K + i * 8192);
  }
  WAIT_VM0();
  RAW_BAR();
  for (int kt = 0; kt < 128; ++kt) {
    if (kt + 1 < 128) {
      unsigned char* l2 = lw + ((kt + 1) & 1) * AT_STAGE;
#pragma unroll
      for (int i = 0; i < 2; ++i) {
        glds16(gk + (size_t)((kt + 1) * 64 + 32 * i) * 1024, l2 + i * 8192);
        glds16(gv + (size_t)(64 * i) * S + (kt + 1) * 64, l2 + AT_K + i * 8192);
      }
    }
    const unsigned char* sm = lds + (kt & 1) * AT_STAGE;
#define SB() __builtin_amdgcn_sched_barrier(0)
#define KFRAG(c, t4, ks) (*(const bf16x8*)(sm + krd + (((t4) >> 1) * 32 + ((t4) & 1) * 4) * 256 + ((((c) * 8 + (ks) * 4 + fg) ^ fr) * 16)))
#define VFRAG(vt, kb) (*(const bf16x8*)(sm + vrd + (vt) * 16 * 128 + ((((kb) * 4 + fg) ^ frs) * 16)))
    bf16x8 kf0[8], kf1[8];
#pragma unroll
    for (int i = 0; i < 8; ++i) kf0[i] = KFRAG(0, i >> 1, i & 1);
    SB();
#pragma unroll
    for (int i = 0; i < 8; ++i) kf1[i] = KFRAG(1, i >> 1, i & 1);
    SB();
    f32x4 s[2][4];
#pragma unroll
    for (int t4 = 0; t4 < 4; ++t4) {
      s[0][t4] = (f32x4){0.f, 0.f, 0.f, 0.f};
      s[0][t4] = __builtin_amdgcn_mfma_f32_16x16x32_bf16(kf0[t4 * 2], qf[0][0], s[0][t4], 0, 0, 0);
      s[0][t4] = __builtin_amdgcn_mfma_f32_16x16x32_bf16(kf0[t4 * 2 + 1], qf[0][1], s[0][t4], 0, 0, 0);
    }
    SB();
    bf16x8 va[4];
#pragma unroll
    for (int i = 0; i < 4; ++i) va[i] = VFRAG(i >> 1, i & 1);
    SB();
#pragma unroll
    for (int t4 = 0; t4 < 4; ++t4) {
      s[1][t4] = (f32x4){0.f, 0.f, 0.f, 0.f};
      s[1][t4] = __builtin_amdgcn_mfma_f32_16x16x32_bf16(kf1[t4 * 2], qf[1][0], s[1][t4], 0, 0, 0);
      s[1][t4] = __builtin_amdgcn_mfma_f32_16x16x32_bf16(kf1[t4 * 2 + 1], qf[1][1], s[1][t4], 0, 0, 0);
    }
    SB();
    float mx[2];
#pragma unroll
    for (int c = 0; c < 2; ++c) {
      mx[c] = fmaxf(fmaxf(s[c][0][0], s[c][0][1]), fmaxf(s[c][0][2], s[c][0][3]));
#pragma unroll
      for (int t4 = 1; t4 < 4; ++t4) mx[c] = fmaxf(mx[c], fmaxf(fmaxf(s[c][t4][0], s[c][t4][1]), fmaxf(s[c][t4][2], s[c][t4][3])));
    }
    if (__any((mx[0] > mrun[0] + 8.f) | (mx[1] > mrun[1] + 8.f))) {
#pragma unroll
      for (int c = 0; c < 2; ++c) {
        float m2 = fmaxf(mx[c], __shfl_xor(mx[c], 16));
        m2 = fmaxf(m2, __shfl_xor(m2, 32));
        const float mn = fmaxf(mrun[c], m2);
        const float alpha = __builtin_amdgcn_exp2f(mrun[c] - mn);
        mrun[c] = mn;
        lrun[c] *= alpha;
#pragma unroll
        for (int i = 0; i < 8; ++i) o[c][i] = o[c][i] * alpha;
      }
    }
    bf16x8 pf[2][2];
#pragma unroll
    for (int c = 0; c < 2; ++c) {
      const float mr = mrun[c];
      float ps = 0.f;
#pragma unroll
      for (int t4 = 0; t4 < 4; ++t4)
#pragma unroll
        for (int j = 0; j < 4; ++j) {
          s[c][t4][j] = __builtin_amdgcn_exp2f(s[c][t4][j] - mr);
          ps += s[c][t4][j];
        }
      lrun[c] += ps;
#pragma unroll
      for (int kb = 0; kb < 2; ++kb) {
        u32x4 w;
        w.x = pk2(s[c][2 * kb][0], s[c][2 * kb][1]);
        w.y = pk2(s[c][2 * kb][2], s[c][2 * kb][3]);
        w.z = pk2(s[c][2 * kb + 1][0], s[c][2 * kb + 1][1]);
        w.w = pk2(s[c][2 * kb + 1][2], s[c][2 * kb + 1][3]);
        pf[c][kb] = __builtin_bit_cast(bf16x8, w);
      }
    }
    SB();
#pragma unroll
    for (int g = 0; g < 4; ++g) {
      bf16x8 vb[4];
      if (g < 3) {
#pragma unroll
        for (int i = 0; i < 4; ++i) vb[i] = VFRAG(2 * g + 2 + (i >> 1), i & 1);
      }
      SB();
#pragma unroll
      for (int i = 0; i < 4; ++i) {
        o[0][2 * g + (i >> 1)] = __builtin_amdgcn_mfma_f32_16x16x32_bf16(va[i], pf[0][i & 1], o[0][2 * g + (i >> 1)], 0, 0, 0);
        o[1][2 * g + (i >> 1)] = __builtin_amdgcn_mfma_f32_16x16x32_bf16(va[i], pf[1][i & 1], o[1][2 * g + (i >> 1)], 0, 0, 0);
      }
      SB();
      if (g < 3) {
#pragma unroll
        for (int i = 0; i < 4; ++i) va[i] = vb[i];
      }
    }
#undef SB
#undef KFRAG
#undef VFRAG
    WAIT_VM0();
    RAW_BAR();
  }
  float l0 = lrun[0], l1 = lrun[1];
  l0 += __shfl_xor(l0, 16); l0 += __shfl_xor(l0, 32);
  l1 += __shfl_xor(l1, 16); l1 += __shfl_xor(l1, 32);
  const float i0 = 1.f / l0, i1 = lam / l1;
  float ss = 0.f;
#pragma unroll
  for (int vt = 0; vt < 8; ++vt) {
    o[0][vt] = o[0][vt] * i0 - o[1][vt] * i1;
#pragma unroll
    for (int j = 0; j < 4; ++j) ss += o[0][vt][j] * o[0][vt][j];
  }
  ss += __shfl_xor(ss, 16);
  ss += __shfl_xor(ss, 32);
  const float rs = rsqrtf(ss * (1.f / 128.f) + 1e-6f) * 0.8f;
#pragma unroll
  for (int vt = 0; vt < 8; ++vt) {
    const int vd = vt * 16 + fg * 4;
    const f32x4 g4 = *(const f32x4*)(p.subln + vd);
    st_bf4(YC + (size_t)(q0 + fr) * 1024 + h * 128 + vd, o[0][vt] * g4 * rs);
  }
}


#ifndef STOP
#define STOP 99
#endif
DI void digest(const Params& p, int which, int bid, int nb, int tid) {
  const unsigned char* ws = p.ws;
  for (size_t i = (size_t)bid * 512 + tid; i < (size_t)T * 1024; i += (size_t)nb * 512) {
    const size_t t = i >> 10; const int c = (int)(i & 1023);
    float v = 0.f;
    if (which == 3) {
      v = bf2f(((const bf16_t*)(ws + O_QK))[i]);
      if (c < 512) {
        const size_t o = t * 512 + c;
        v += bf2f(((const bf16_t*)(ws + O_VT))[o]) + bf2f(((const bf16_t*)(ws + O_RS))[o]) + bf2f(((const bf16_t*)(ws + O_KS))[o]) +
             bf2f(((const bf16_t*)(ws + O_VS))[o]) + bf2f(((const bf16_t*)(ws + O_KK))[o]) + bf2f(((const bf16_t*)(ws + O_E0))[o]) +
             bf2f(((const bf16_t*)(ws + O_E1))[o]) + bf2f(((const bf16_t*)(ws + O_A0))[o]) + bf2f(((const bf16_t*)(ws + O_A1))[o]) +
             bf2f(((const bf16_t*)(ws + O_GG))[o]);
      }
    } else if (which == 0) {
      v = bf2f(((const bf16_t*)(ws + O_XB))[i]) + ((const float*)(ws + O_RSTD1))[t] + bf2f(((const bf16_t*)(ws + O_WINT))[i % (size_t)(3456 * 1024)]) +
          bf2f(((const bf16_t*)(ws + O_WUPT))[i % (size_t)(5632 * 1024)]) + bf2f(((const bf16_t*)(ws + O_WDOWNT))[i % (size_t)(2816 * 1024)]) +
          bf2f(((const bf16_t*)(ws + O_WOUTT))[i % (size_t)(1024 * 1024)]) + bf2f(((const bf16_t*)(ws + O_W2T))[i % (size_t)(196608)]) +
          ((const float*)(ws + O_ROPE))[i % (size_t)(8192 * 64)];
    } else if (which == 1) {
      v = bf2f(((const bf16_t*)(ws + O_QK))[i]);
      if (c < 512) v += bf2f(((const bf16_t*)(ws + O_VT))[t * 512 + c]);
      v += bf2f(((const bf16_t*)(ws + O_Z))[t * 1920 + c]);
      if (c < 896) v += bf2f(((const bf16_t*)(ws + O_Z))[t * 1920 + 1024 + c]);
    } else if (which == 2) {
      if (c < 512) {
        const size_t o = t * 512 + c;
        v = bf2f(((const bf16_t*)(ws + O_RS))[o]) + bf2f(((const bf16_t*)(ws + O_KS))[o]) + bf2f(((const bf16_t*)(ws + O_VS))[o]) + bf2f(((const bf16_t*)(ws + O_KK))[o]);
      } else if (c < 896) v = bf2f(((const bf16_t*)(ws + O_LIN))[t * 384 + c - 512]);
    } else if (which == 6) {
      v = bf2f(((const bf16_t*)(ws + O_YCAT))[i]);
    }
    p.out[i] = v;
  }
}

__global__ void __launch_bounds__(512) mega(Params p) {
  cg::grid_group grid = cg::this_grid();
  extern __shared__ __attribute__((aligned(16))) unsigned char lds[];
  __shared__ int s_item;
  const int tid = threadIdx.x, bid = blockIdx.x, nb = gridDim.x, lane = tid & 63, wave = tid >> 6;
  const int gw = bid * 8 + wave, ngw = nb * 8;
  unsigned char* ws = p.ws;
  float* rstd1 = (float*)(ws + O_RSTD1);
  float* rstd2 = (float*)(ws + O_RSTD2);
  float* misc = (float*)(ws + O_MISC);
  unsigned* gbar = (unsigned*)(ws + O_MISC + 4096);

  {
    bf16_t* xb = (bf16_t*)(ws + O_XB);
    for (int row = gw; row < T; row += ngw) {
      const f32x4* xr = (const f32x4*)(p.x + (size_t)row * D) + lane;
      f32x4 v[4];
      float s = 0.f;
#pragma unroll
      for (int j = 0; j < 4; ++j) {
        v[j] = xr[64 * j];
        s += v[j][0] * v[j][0] + v[j][1] * v[j][1] + v[j][2] * v[j][2] + v[j][3] * v[j][3];
      }
      s = wave_sum(s);
      if (lane == 0) rstd1[row] = rsqrtf(s * (1.f / D) + 1e-6f);
      bf16_t* orow = xb + (size_t)row * D + lane * 4;
#pragma unroll
      for (int j = 0; j < 4; ++j) st_bf4(orow + 256 * j, v[j]);
    }
    float* tile = (float*)lds;
    transpose_job(p.w_in, D, NIN, (bf16_t*)(ws + O_WINT), p.pre_mix, true, tile, bid, nb, tid);
    transpose_job(p.w_out, D, D, (bf16_t*)(ws + O_WOUTT), nullptr, false, tile, bid, nb, tid);
    transpose_job(p.w_up, D, 2 * DFF, (bf16_t*)(ws + O_WUPT), p.pre_ffn, false, tile, bid, nb, tid);
    transpose_job(p.w_down, DFF, D, (bf16_t*)(ws + O_WDOWNT), nullptr, false, tile, bid, nb, tid);
    transpose_job(p.w2, 64, 512, (bf16_t*)(ws + O_W2T), nullptr, false, tile, bid, nb, tid);
    transpose_job(p.w2 + 64 * 512, 64, 512, (bf16_t*)(ws + O_W2T) + 512 * 64, nullptr, false, tile, bid, nb, tid);
    transpose_job(p.a2, 64, 512, (bf16_t*)(ws + O_A2T), nullptr, false, tile, bid, nb, tid);
    transpose_job(p.a2 + 64 * 512, 64, 512, (bf16_t*)(ws + O_A2T) + 512 * 64, nullptr, false, tile, bid, nb, tid);
    transpose_job(p.g2, 128, 512, (bf16_t*)(ws + O_G2T), nullptr, false, tile, bid, nb, tid);
    f32x2* rope = (f32x2*)(ws + O_ROPE);
    for (int i = bid * 512 + tid; i < S * 32; i += nb * 512) {
      const int s = i >> 5, f = i & 31;
      const float inv = powf(10000.f, -(float)f / 32.f);
      const float ang = (float)s * inv;
      rope[i] = (f32x2){cosf(ang), sinf(ang)};
    }
    if (bid == 0 && tid == 0) {
      float s1 = 0.f, s2 = 0.f;
      for (int i = 0; i < 64; ++i) {
        s1 += p.lq1[i] * p.lk1[i];
        s2 += p.lq2[i] * p.lk2[i];
      }
      misc[0] = expf(s1) - expf(s2) + 0.2f;
      for (int i = 0; i < 8; ++i) ((int*)misc)[16 + i * 16] = 0;
    }
  }
  grid.sync();
  if (STOP == 0) { digest(p, 0, bid, nb, tid); return; }

  {
    const bf16_t* xb = (const bf16_t*)(ws + O_XB);
    const bf16_t* wt = (const bf16_t*)(ws + O_WINT);
    EpiInProj e1{rstd1, (const f32x2*)(ws + O_ROPE), (bf16_t*)(ws + O_QK), (bf16_t*)(ws + O_Z)};
    EpiV ev{rstd1, (bf16_t*)(ws + O_VT)};
    for (int r = 0;; ++r) {
      int mt, nt;
      if (!tile_of(r, bid, nb, 14, mt, nt)) break;
      if (nt == 4 || nt == 5) gemm_tile<true>(xb, D, wt, D, D, mt * 256, nt * 256, lds, ev, tid);
      else gemm_tile<false>(xb, D, wt, D, D, mt * 256, nt * 256, lds, e1, tid);
    }
  }
  gsync(gbar, bid, nb, 1u);

  {
    const bf16_t* Z = (const bf16_t*)(ws + O_Z);
    bf16_t* RS = (bf16_t*)(ws + O_RS);
    bf16_t* KS = (bf16_t*)(ws + O_KS);
    bf16_t* VS = (bf16_t*)(ws + O_VS);
    bf16_t* KK = (bf16_t*)(ws + O_KK);
    bf16_t* LIN = (bf16_t*)(ws + O_LIN);
    for (int t = gw; t < T; t += ngw) {
      const int s = t & (S - 1);
      const bool hp = s > 0, hn = s < S - 1;
      const bf16_t* zc = Z + (size_t)t * NRW;
      u32x2 z0[8], zp[8], zn[8];
#pragma unroll
      for (int it = 0; it < 8; ++it) {
        const int c = it * 256 + lane * 4;
        const bool ok = (it < 7) || (lane < 32);
        z0[it] = ok ? *(const u32x2*)(zc + c) : (u32x2){0u, 0u};
        zp[it] = (ok && hp) ? *(const u32x2*)(zc + c - NRW) : (u32x2){0u, 0u};
        zn[it] = (ok && hn) ? *(const u32x2*)(zc + c + NRW) : (u32x2){0u, 0u};
      }
#pragma unroll
      for (int it = 0; it < 8; ++it) {
        const int c = it * 256 + lane * 4;
        const bool ok = (it < 7) || (lane < 32);
        f32x4 m4 = (f32x4){0.f, 0.f, 0.f, 0.f};
        if (ok) m4 = *(const f32x4*)(p.mu + c);
        f32x4 a, pv, nx, v;
        a[0] = bflo(z0[it].x); a[1] = bfhi(z0[it].x); a[2] = bflo(z0[it].y); a[3] = bfhi(z0[it].y);
        pv[0] = bflo(zp[it].x); pv[1] = bfhi(zp[it].x); pv[2] = bflo(zp[it].y); pv[3] = bfhi(zp[it].y);
        nx[0] = bflo(zn[it].x); nx[1] = bfhi(zn[it].x); nx[2] = bflo(zn[it].y); nx[3] = bfhi(zn[it].y);
#pragma unroll
        for (int j = 0; j < 4; ++j) v[j] = a[j] + (0.5f * (pv[j] + nx[j]) - a[j]) * m4[j];
        if (it < 2) {
          st_bf4(RS + (size_t)t * 512 + c, v);
        } else if (it < 4) {
          const int cc = c - 512;
          st_bf4(KS + (size_t)t * 512 + cc, v);
          const f32x4 kk = *(const f32x4*)(p.k_k + cc);
          f32x4 f = v * kk;
          float ss = f[0] * f[0] + f[1] * f[1] + f[2] * f[2] + f[3] * f[3];
          ss = row_sum16(ss);
          const float rn = rsqrtf(fmaxf(ss, 1e-12f));
          st_bf4(KK + (size_t)t * 512 + cc, f * rn);
        } else if (it < 6) {
          st_bf4(VS + (size_t)t * 512 + (c - 1024), v);
        } else if (it == 6) {
          f32x4 o;
          if (lane < 32) { o[0] = tanhf(v[0]); o[1] = tanhf(v[1]); o[2] = tanhf(v[2]); o[3] = tanhf(v[3]); }
          else o = v;
          st_bf4(LIN + (size_t)t * 384 + (c - 1536), o);
        } else if (lane < 32) {
          f32x4 o;
          o[0] = sigmoidf_(v[0]); o[1] = sigmoidf_(v[1]); o[2] = sigmoidf_(v[2]); o[3] = sigmoidf_(v[3]);
          st_bf4(LIN + (size_t)t * 384 + (c - 1536), o);
        }
      }
    }
  }
  gsync(gbar, bid, nb, 2u);
  if (STOP == 2) { digest(p, 2, bid, nb, tid); return; }

  {
    const bf16_t* LIN = (const bf16_t*)(ws + O_LIN);
    const bf16_t* W2T = (const bf16_t*)(ws + O_W2T);
    const bf16_t* A2T = (const bf16_t*)(ws + O_A2T);
    const bf16_t* G2T = (const bf16_t*)(ws + O_G2T);
#pragma unroll 1
    for (int job = 0; job < 5; ++job) {
      const int d = job & 1;
      const bf16_t* Aj = job < 2 ? LIN + d * 64 : (job < 4 ? LIN + 128 + d * 64 : LIN + 256);
      const bf16_t* Bj = job < 2 ? W2T + d * 512 * 64 : (job < 4 ? A2T + d * 512 * 64 : G2T);
      const int Kj = job < 4 ? 64 : 128;
      const size_t oo = job < 2 ? (d ? O_E1 : O_E0) : (job < 4 ? (d ? O_A1 : O_A0) : O_GG);
      EpiLora ej{job < 2 ? 0 : (job < 4 ? 1 : 2), job < 2 ? p.w0 + d * 512 : p.a0 + d * 512, (bf16_t*)(ws + oo)};
      gemm_phase<false>(Aj, 384, Bj, Kj, Kj, 2, 0, 2, lds, ej, bid, nb, tid);
    }
  }
  gsync(gbar, bid, nb, 3u);
  if (STOP == 3) { digest(p, 3, bid, nb, tid); return; }

  {
    const float lam = misc[0];
    const int grp = bid & 7;
    int* counter = (int*)misc + 16 + grp * 16;
    for (;;) {
      if (tid == 0) s_item = atomicAdd(counter, 1);
      __syncthreads();
      const int item = s_item;
      __syncthreads();
      if (item >= 16 + 256) break;
      if (item < 16) scan_chain(p, grp * 16 + item, lds, tid);
      else attn_item(p, grp * 256 + (item - 16), lam, lds, tid);
    }
  }
  gsync(gbar, bid, nb, 4u);

  {
    const float* Y0 = p.out;
    const float* Y1 = p.out + (size_t)T * 512;
    const bf16_t* RS = (const bf16_t*)(ws + O_RS);
    const bf16_t* KS = (const bf16_t*)(ws + O_KS);
    const bf16_t* VS = (const bf16_t*)(ws + O_VS);
    const bf16_t* A0 = (const bf16_t*)(ws + O_A0);
    const bf16_t* A1 = (const bf16_t*)(ws + O_A1);
    const bf16_t* GG = (const bf16_t*)(ws + O_GG);
    bf16_t* YC = (bf16_t*)(ws + O_YCAT);
#pragma unroll 2
    for (int idx = gw; idx < T * 2; idx += ngw) {
      const int t = idx >> 1, c = (idx & 1) * 256 + lane * 4;
      const size_t o = (size_t)t * 512 + c;
      const f32x4 ya = *(const f32x4*)(Y0 + o), yb = *(const f32x4*)(Y1 + o);
      const u32x2 rr = *(const u32x2*)(RS + o), kr = *(const u32x2*)(KS + o), vr = *(const u32x2*)(VS + o);
      const u32x2 a0r = *(const u32x2*)(A0 + o), a1r = *(const u32x2*)(A1 + o), gr = *(const u32x2*)(GG + o);
      const f32x4 gw4 = *(const f32x4*)(p.gn_w + c), gb4 = *(const f32x4*)(p.gn_b + c), ka4 = *(const f32x4*)(p.k_a + c), rk4 = *(const f32x4*)(p.r_k + c);
      const f32x4 y = ya + yb;
      const float mean = row_sum16(y[0] + y[1] + y[2] + y[3]) * (1.f / 64.f);
      const f32x4 dl = y - mean;
      const float var = row_sum16(dl[0] * dl[0] + dl[1] * dl[1] + dl[2] * dl[2] + dl[3] * dl[3]) * (1.f / 64.f);
      const float rs = rsqrtf(var + 64e-5f);
      f32x4 r, k, v, a0, a1, g;
      r[0] = bflo(rr.x); r[1] = bfhi(rr.x); r[2] = bflo(rr.y); r[3] = bfhi(rr.y);
      k[0] = bflo(kr.x); k[1] = bfhi(kr.x); k[2] = bflo(kr.y); k[3] = bfhi(kr.y);
      v[0] = bflo(vr.x); v[1] = bfhi(vr.x); v[2] = bflo(vr.y); v[3] = bfhi(vr.y);
      a0[0] = bflo(a0r.x); a0[1] = bfhi(a0r.x); a0[2] = bflo(a0r.y); a0[3] = bfhi(a0r.y);
      a1[0] = bflo(a1r.x); a1[1] = bfhi(a1r.x); a1[2] = bflo(a1r.y); a1[3] = bfhi(a1r.y);
      g[0] = bflo(gr.x); g[1] = bfhi(gr.x); g[2] = bflo(gr.y); g[3] = bfhi(gr.y);
      float bp = 0.f;
#pragma unroll
      for (int j = 0; j < 4; ++j) bp += r[j] * (k[j] * (2.f + (a0[j] + a1[j] - 2.f) * ka4[j])) * rk4[j];
      const float bs = row_sum16(bp);
      f32x4 out;
#pragma unroll
      for (int j = 0; j < 4; ++j) out[j] = (dl[j] * rs * gw4[j] + gb4[j] + bs * v[j]) * g[j];
      st_bf4(YC + (size_t)t * 1024 + 512 + c, out);
    }
  }
  gsync(gbar, bid, nb, 5u);
  if (STOP == 6) { digest(p, 6, bid, nb, tid); return; }

  {
    EpiB16 e{(bf16_t*)(ws + O_MIX), D};
    gemm_phase<false>((const bf16_t*)(ws + O_YCAT), D, (const bf16_t*)(ws + O_WOUTT), D, D, 4, 0, 4, lds, e, bid, nb, tid);
  }
  gsync(gbar, bid, nb, 6u);

  {
    const bf16_t* mix = (const bf16_t*)(ws + O_MIX);
    bf16_t* x1b = (bf16_t*)(ws + O_X1B);
    for (int row = gw; row < T; row += ngw) {
      const u32x2* mr = (const u32x2*)(mix + (size_t)row * D) + lane;
      const f32x4* xr = (const f32x4*)(p.x + (size_t)row * D) + lane;
      const f32x4* gr = (const f32x4*)(p.post_mix) + lane;
      f32x4 mv[4];
      float s = 0.f;
#pragma unroll
      for (int j = 0; j < 4; ++j) {
        { const u32x2 q_ = mr[64 * j]; mv[j][0] = bflo(q_.x); mv[j][1] = bfhi(q_.x); mv[j][2] = bflo(q_.y); mv[j][3] = bfhi(q_.y); }
        s += mv[j][0] * mv[j][0] + mv[j][1] * mv[j][1] + mv[j][2] * mv[j][2] + mv[j][3] * mv[j][3];
      }
      const float rs = rsqrtf(wave_sum(s) * (1.f / D) + 1e-6f);
      float s2 = 0.f;
      f32x4* orow = (f32x4*)(p.out + (size_t)row * D) + lane;
#pragma unroll
      for (int j = 0; j < 4; ++j) {
        mv[j] = xr[64 * j] + mv[j] * rs * gr[64 * j];
        s2 += mv[j][0] * mv[j][0] + mv[j][1] * mv[j][1] + mv[j][2] * mv[j][2] + mv[j][3] * mv[j][3];
        orow[64 * j] = mv[j];
        st_bf4(x1b + (size_t)row * D + lane * 4 + 256 * j, mv[j]);
      }
      s2 = wave_sum(s2);
      if (lane == 0) rstd2[row] = rsqrtf(s2 * (1.f / D) + 1e-6f);
    }
  }
  gsync(gbar, bid, nb, 7u);

  {
    EpiGate e{rstd2, (bf16_t*)(ws + O_G)};
    gemm_phase<false>((const bf16_t*)(ws + O_X1B), D, (const bf16_t*)(ws + O_WUPT), D, D, 11, 0, 11, lds, e, bid, nb, tid);
  }
  gsync(gbar, bid, nb, 8u);

  {
    EpiUp e{rstd2, (const bf16_t*)(ws + O_G), p.conv_w, p.conv_b, (bf16_t*)(ws + O_ACT)};
    gemm_phase<false>((const bf16_t*)(ws + O_X1B), D, (const bf16_t*)(ws + O_WUPT) + (size_t)DFF * D, D, D, 11, 0, 11, lds, e, bid, nb, tid);
  }
  gsync(gbar, bid, nb, 9u);

  {
    EpiB16 e{(bf16_t*)(ws + O_F), D};
    gemm_phase<false>((const bf16_t*)(ws + O_ACT), DFF, (const bf16_t*)(ws + O_WDOWNT), DFF, DFF, 4, 0, 4, lds, e, bid, nb, tid);
  }
  gsync(gbar, bid, nb, 10u);

  {
    const bf16_t* f = (const bf16_t*)(ws + O_F);
    for (int row = gw; row < T; row += ngw) {
      const u32x2* fr_ = (const u32x2*)(f + (size_t)row * D) + lane;
      const f32x4* gr = (const f32x4*)(p.post_ffn) + lane;
      f32x4* orow = (f32x4*)(p.out + (size_t)row * D) + lane;
      f32x4 fv[4];
      float s = 0.f;
#pragma unroll
      for (int j = 0; j < 4; ++j) {
        { const u32x2 q_ = fr_[64 * j]; fv[j][0] = bflo(q_.x); fv[j][1] = bfhi(q_.x); fv[j][2] = bflo(q_.y); fv[j][3] = bfhi(q_.y); }
        s += fv[j][0] * fv[j][0] + fv[j][1] * fv[j][1] + fv[j][2] * fv[j][2] + fv[j][3] * fv[j][3];
      }
      const float rs = rsqrtf(wave_sum(s) * (1.f / D) + 1e-6f);
#pragma unroll
      for (int j = 0; j < 4; ++j) orow[64 * j] = orow[64 * j] + fv[j] * rs * gr[64 * j];
    }
  }
}

extern "C" void kernel_launch(void* const* d_in, const int* in_sizes, int n_in, void* d_out, int out_size, void* d_ws, size_t ws_size,
                              hipStream_t stream) {
  static int grid_blocks = 0;
  if (grid_blocks == 0) {
    if (n_in != 27 || in_sizes[0] != T * D || out_size != T * D || ws_size < WS_END) {
      fprintf(stderr, "kernel_launch: unexpected shapes (n_in %d, in0 %d, out %d, ws %zu)\n", n_in, n_in > 0 ? in_sizes[0] : -1, out_size, ws_size);
      grid_blocks = -1;
      return;
    }
    int dev = 0, cus = 0, per_cu = 0;
    (void)hipGetDevice(&dev);
    (void)hipDeviceGetAttribute(&cus, hipDeviceAttributeMultiprocessorCount, dev);
    (void)hipFuncSetAttribute((const void*)mega, hipFuncAttributeMaxDynamicSharedMemorySize, LDS_BYTES);
    (void)hipOccupancyMaxActiveBlocksPerMultiprocessor(&per_cu, (const void*)mega, 512, LDS_BYTES);
    if (per_cu < 1) per_cu = 1;
    grid_blocks = cus * per_cu;
  }
  if (grid_blocks < 0) return;
  Params p{};
  const float** pp = (const float**)&p;
  for (int i = 0; i < 27; ++i) pp[i] = (const float*)d_in[i];
  p.out = (float*)d_out;
  p.ws = (unsigned char*)d_ws;
  (void)hipMemsetAsync((char*)d_ws + O_MISC + 4096, 0, 4096, stream);
  void* args[] = {&p};
  hipError_t e = hipLaunchCooperativeKernel((const void*)mega, dim3(grid_blocks), dim3(512), args, LDS_BYTES, stream);
  if (e != hipSuccess) fprintf(stderr, "cooperative launch failed: %s (grid %d)\n", hipGetErrorString(e), grid_blocks);
}
```

```cpp
#include <hip/hip_runtime.h>
#include <hip/hip_cooperative_groups.h>
#include <cstdio>
namespace cg = cooperative_groups;

typedef unsigned short bf16_t;
typedef short bf16x8 __attribute__((ext_vector_type(8)));
typedef float f32x4 __attribute__((ext_vector_type(4)));
typedef float f32x2 __attribute__((ext_vector_type(2)));
typedef unsigned int u32;
typedef u32 u32x4 __attribute__((ext_vector_type(4)));
typedef u32 u32x2 __attribute__((ext_vector_type(2)));

#define DI __device__ __forceinline__

constexpr int T = 65536, S = 8192, D = 1024, NIN = 3456, NRW = 1920, DFF = 2816;
constexpr size_t MiB = 1ull << 20;
constexpr size_t O_WINT = 0, O_WOUTT = 7 * MiB, O_WUPT = 9 * MiB, O_WDOWNT = 20 * MiB;
constexpr size_t O_W2T = 26 * MiB, O_A2T = O_W2T + 131072, O_G2T = O_W2T + 262144;
constexpr size_t O_ROPE = 27 * MiB, O_RSTD1 = 29 * MiB, O_RSTD2 = O_RSTD1 + 262144, O_MISC = 30 * MiB;
constexpr size_t O_XB = 32 * MiB, O_LIN = 32 * MiB, O_YCAT = 32 * MiB, O_ACT = 32 * MiB;
constexpr size_t O_QK = 160 * MiB, O_VT = 288 * MiB, O_MIX = 160 * MiB;
constexpr size_t O_Z = 352 * MiB, O_E0 = 352 * MiB, O_E1 = 416 * MiB, O_A0 = 480 * MiB, O_A1 = 544 * MiB, O_GG = 608 * MiB;
constexpr size_t O_RS = 672 * MiB, O_KS = 736 * MiB, O_VS = 800 * MiB, O_KK = 864 * MiB;
constexpr size_t O_X1B = 416 * MiB, O_G = 544 * MiB, O_F = 544 * MiB;
constexpr size_t WS_END = 928 * MiB;

constexpr int LDS_BYTES = 131072;
constexpr float QSCALE = 0.125f * 1.4426950408889634f;

struct Params {
  const float *x, *pre_mix, *post_mix, *pre_ffn, *post_ffn, *w_in, *lq1, *lk1, *lq2, *lk2, *subln, *mu, *w0, *w2, *a0, *a2, *g2,
      *k_k, *k_a, *r_k, *gn_w, *gn_b, *w_out, *w_up, *conv_w, *conv_b, *w_down;
  float* out;
  unsigned char* ws;
};

typedef __bf16 bf16x2_t __attribute__((ext_vector_type(2)));
DI u32 pk2(float lo, float hi) {
  f32x2 f = {lo, hi};
  bf16x2_t b = __builtin_convertvector(f, bf16x2_t);
  return __builtin_bit_cast(u32, b);
}
DI bf16_t f2bf(float f) { return (bf16_t)(pk2(f, 0.f) & 0xffffu); }
DI float bf2f(u32 h) { return __uint_as_float(h << 16); }
DI float bflo(u32 w) { return __uint_as_float(w << 16); }
DI float bfhi(u32 w) { return __uint_as_float(w & 0xffff0000u); }
DI void st_bf4(bf16_t* p, f32x4 v) {
  u32x2 o;
  o.x = pk2(v[0], v[1]);
  o.y = pk2(v[2], v[3]);
  *(u32x2*)p = o;
}
DI float wave_sum(float v) {
#pragma unroll
  for (int o = 1; o < 64; o <<= 1) v += __shfl_xor(v, o);
  return v;
}
DI float sigmoidf_(float u) { return 1.f / (1.f + __expf(-u)); }
template <int CTRL>
DI float dppf(float v) {
  return __builtin_bit_cast(float, __builtin_amdgcn_update_dpp(0, __builtin_bit_cast(int, v), CTRL, 0xF, 0xF, true));
}
DI float row_sum16(float v) {
  v += dppf<0x128>(v);
  v += dppf<0x124>(v);
  v += dppf<0x122>(v);
  v += dppf<0x121>(v);
  return v;
}


DI void gsync(unsigned* bar, unsigned target) {
  __threadfence();
  __syncthreads();
  if (threadIdx.x == 0) {
    __hip_atomic_fetch_add(bar, 1u, __ATOMIC_RELEASE, __HIP_MEMORY_SCOPE_AGENT);
    while (__hip_atomic_load(bar, __ATOMIC_RELAXED, __HIP_MEMORY_SCOPE_AGENT) < target) __builtin_amdgcn_s_sleep(2);
  }
  __syncthreads();
  __builtin_amdgcn_fence(__ATOMIC_ACQUIRE, "agent");
}

typedef __attribute__((address_space(3))) unsigned int lds_u32;
DI void glds16(const void* g, unsigned char* l) {
  __builtin_amdgcn_global_load_lds((const unsigned*)g, (lds_u32*)l, 16, 0, 0);
}
#define WAIT_VM0() asm volatile("s_waitcnt vmcnt(0)" ::: "memory")
#define RAW_BAR() __builtin_amdgcn_s_barrier()

DI void gsync(unsigned* bar, int bid, int nb, unsigned k) {
  WAIT_VM0();
  __syncthreads();
  if (threadIdx.x == 0) {
    __builtin_amdgcn_fence(__ATOMIC_RELEASE, "agent");
    WAIT_VM0();
    if ((nb & 7) == 0) {
      const unsigned gsz = (unsigned)nb >> 3;
      const unsigned old = __hip_atomic_fetch_add(bar + 64 * (1 + (bid & 7)), 1u, __ATOMIC_RELAXED, __HIP_MEMORY_SCOPE_AGENT);
      if (old == gsz * k - 1u) __hip_atomic_fetch_add(bar, 1u, __ATOMIC_RELAXED, __HIP_MEMORY_SCOPE_AGENT);
      while (__hip_atomic_load(bar, __ATOMIC_RELAXED, __HIP_MEMORY_SCOPE_AGENT) < 8u * k) __builtin_amdgcn_s_sleep(1);
    } else {
      __hip_atomic_fetch_add(bar, 1u, __ATOMIC_RELAXED, __HIP_MEMORY_SCOPE_AGENT);
      while (__hip_atomic_load(bar, __ATOMIC_RELAXED, __HIP_MEMORY_SCOPE_AGENT) < (unsigned)nb * k) __builtin_amdgcn_s_sleep(1);
    }
    __builtin_amdgcn_fence(__ATOMIC_ACQUIRE, "agent");
    WAIT_VM0();
  }
  __syncthreads();
}

DI void transpose_job(const float* src, int K, int N, bf16_t* dst, const float* g, bool perm, float* tile, int bid, int nb, int tid) {
  const int nnt = N / 64, nit = (K / 64) * nnt;
  for (int it = bid; it < nit; it += nb) {
    const int kt = it / nnt, nt = it % nnt, k0 = kt * 64, n0 = nt * 64;
#pragma unroll
    for (int i = 0; i < 8; ++i) {
      const int kk = (tid >> 6) + 8 * i, nn = tid & 63;
      float v = src[(size_t)(k0 + kk) * N + n0 + nn];
      if (g) v *= g[k0 + kk];
      tile[kk * 65 + nn] = v;
    }
    __syncthreads();
#pragma unroll
    for (int i = 0; i < 8; ++i) {
      const int nn = (tid >> 6) + 8 * i, kk = tid & 63;
      const int n = n0 + nn;
      int nd = n;
      if (perm && n < 1024) {
        const int d = n & 63;
        nd = (n & ~63) | (2 * (d & 31) + (d >> 5));
      }
      dst[(size_t)nd * K + k0 + kk] = f2bf(tile[kk * 65 + nn]);
    }
    __syncthreads();
  }
}

constexpr int G_ASTAGE = 256 * 128, G_BSTAGE = 256 * 128, G_STAGE = G_ASTAGE + G_BSTAGE;

template <bool SWAP, class Epi>
DI void gemm_tile(const bf16_t* __restrict__ A, int lda, const bf16_t* __restrict__ Bt, int ldb, int K, int m0, int n0,
                  unsigned char* lds, const Epi& epi, int tid) {
  const int lane = tid & 63, wave = tid >> 6, wm = wave >> 2, wn = wave & 3, fr = lane & 15, fg = lane >> 4;
  f32x4 acc[8][4];
#pragma unroll
  for (int i = 0; i < 8; ++i)
#pragma unroll
    for (int j = 0; j < 4; ++j) acc[i][j] = (f32x4){0.f, 0.f, 0.f, 0.f};
  const int nk = K / 64;
  const int srow = tid >> 3, skc = tid & 7;
  const int gch = skc ^ ((srow >> 1) & 7);
  const int frs = (fr >> 1) & 7;
  const bf16_t* ga = A + (size_t)(m0 + srow) * lda + gch * 8;
  const bf16_t* gb = Bt + (size_t)(n0 + srow) * ldb + gch * 8;
  unsigned char* lw = lds + tid * 16;
#pragma unroll
  for (int i = 0; i < 4; ++i) glds16(ga + (size_t)(64 * i) * lda, lw + i * 8192);
#pragma unroll
  for (int i = 0; i < 4; ++i) glds16(gb + (size_t)(64 * i) * ldb, lw + G_ASTAGE + i * 8192);
  WAIT_VM0();
  RAW_BAR();
  const int aoff = (wm * 128 + fr) * 128, boff = G_ASTAGE + (wn * 64 + fr) * 128;
  const int c0 = ((0 * 4 + fg) ^ frs) * 16, c1 = ((1 * 4 + fg) ^ frs) * 16;
#define SB() __builtin_amdgcn_sched_barrier(0)
#define MMA16(AF, KS, MB)                                                                                                          \
  _Pragma("unroll") for (int mi = 0; mi < 4; ++mi) _Pragma("unroll") for (int ni = 0; ni < 4; ++ni) {                              \
    if (SWAP) acc[(MB) + mi][ni] = __builtin_amdgcn_mfma_f32_16x16x32_bf16(AF[mi], bfr[KS][ni], acc[(MB) + mi][ni], 0, 0, 0);     \
    else acc[(MB) + mi][ni] = __builtin_amdgcn_mfma_f32_16x16x32_bf16(bfr[KS][ni], AF[mi], acc[(MB) + mi][ni], 0, 0, 0);          \
  }
  for (int kt = 0; kt < nk; ++kt) {
    if (kt + 1 < nk) {
      unsigned char* l2 = lw + ((kt + 1) & 1) * G_STAGE;
#pragma unroll
      for (int i = 0; i < 4; ++i) glds16(ga + (size_t)(64 * i) * lda + (kt + 1) * 64, l2 + i * 8192);
#pragma unroll
      for (int i = 0; i < 4; ++i) glds16(gb + (size_t)(64 * i) * ldb + (kt + 1) * 64, l2 + G_ASTAGE + i * 8192);
    }
    const unsigned char* st = lds + (kt & 1) * G_STAGE;
    bf16x8 bfr[1][4], ax[4], ay[4];
#pragma unroll
    for (int i = 0; i < 4; ++i) bfr[0][i] = *(const bf16x8*)(st + boff + i * 2048 + c0);
#pragma unroll
    for (int i = 0; i < 4; ++i) ax[i] = *(const bf16x8*)(st + aoff + i * 2048 + c0);
    SB();
#pragma unroll
    for (int i = 0; i < 4; ++i) ay[i] = *(const bf16x8*)(st + aoff + (4 + i) * 2048 + c0);
    SB();
    MMA16(ax, 0, 0);
    SB();
#pragma unroll
    for (int i = 0; i < 4; ++i) ax[i] = *(const bf16x8*)(st + aoff + i * 2048 + c1);
    SB();
    MMA16(ay, 0, 4);
    SB();
#pragma unroll
    for (int i = 0; i < 4; ++i) bfr[0][i] = *(const bf16x8*)(st + boff + i * 2048 + c1);
#pragma unroll
    for (int i = 0; i < 4; ++i) ay[i] = *(const bf16x8*)(st + aoff + (4 + i) * 2048 + c1);
    SB();
    MMA16(ax, 0, 0);
    SB();
    MMA16(ay, 0, 4);
    WAIT_VM0();
    RAW_BAR();
  }
#undef MMA16
#undef SB
#pragma unroll
  for (int mi = 0; mi < 8; ++mi)
#pragma unroll
    for (int ni = 0; ni < 4; ++ni) {
      if (SWAP) epi(m0 + wm * 128 + mi * 16 + fg * 4, n0 + wn * 64 + ni * 16 + fr, acc[mi][ni]);
      else epi(m0 + wm * 128 + mi * 16 + fr, n0 + wn * 64 + ni * 16 + fg * 4, acc[mi][ni]);
      __builtin_amdgcn_sched_barrier(0);
    }
}

struct EpiInProj {
  const float* rstd; const f32x2* rope; bf16_t* qk; bf16_t* z;
  DI void operator()(int m, int n, f32x4 v) const {
    if (n >= NIN) return;
    const float rs = rstd[m];
    v = v * rs;
    if (n < 1024) {
      const int s = m & (S - 1), i = (n & 63) >> 1;
      const f32x2 c0 = rope[s * 32 + i], c1 = rope[s * 32 + i + 1];
      float a = v[0], b = v[1];
      v[0] = a * c0.x - b * c0.y; v[1] = b * c0.x + a * c0.y;
      a = v[2]; b = v[3];
      v[2] = a * c1.x - b * c1.y; v[3] = b * c1.x + a * c1.y;
      if (n < 512) v = v * QSCALE;
      st_bf4(qk + (size_t)m * 1024 + n, v);
    } else {
      st_bf4(z + (size_t)m * NRW + (n - 1536), v);
    }
  }
};
struct EpiV {
  const float* rstd; bf16_t* vt;
  DI void operator()(int m, int n, f32x4 v) const {
    const f32x4 rs = *(const f32x4*)(rstd + m);
    v = v * rs;
    const int nn = n - 1024, h = nn >> 7, vd = nn & 127, b = m >> 13, s = m & (S - 1);
    st_bf4(vt + ((size_t)((b * 4 + h) * 128 + vd)) * S + s, v);
  }
};
struct EpiLora {
  int mode; const float* bias; bf16_t* out;
  DI void operator()(int m, int n, f32x4 v) const {
    if (mode < 2) {
      const f32x4 bv = *(const f32x4*)(bias + n);
      const float sc = mode == 0 ? 0.60653065971f : 1.f;
#pragma unroll
      for (int j = 0; j < 4; ++j) v[j] = sc * sigmoidf_(v[j] + bv[j]);
    }
    st_bf4(out + (size_t)m * 512 + n, v);
  }
};
struct EpiB16 {
  bf16_t* out; int ld;
  DI void operator()(int m, int n, f32x4 v) const { st_bf4(out + (size_t)m * ld + n, v); }
};
struct EpiF32 {
  float* out; int ld;
  DI void operator()(int m, int n, f32x4 v) const { *(f32x4*)(out + (size_t)m * ld + n) = v; }
};
struct EpiGate {
  const float* rstd; bf16_t* g;
  DI void operator()(int m, int n, f32x4 v) const { st_bf4(g + (size_t)m * DFF + n, v * rstd[m]); }
};
struct EpiUp {
  const float* rstd; const bf16_t* g; const float* cw; const float* cb; bf16_t* act;
  DI void operator()(int m, int n, f32x4 v) const {
    v = v * rstd[m];
    const int s = m & (S - 1);
    const bf16_t* gp = g + (size_t)m * DFF + n;
    const u32x2 g0 = *(const u32x2*)gp;
    u32x2 gm = (u32x2){0u, 0u}, gn = (u32x2){0u, 0u};
    if (s > 0) gm = *(const u32x2*)(gp - DFF);
    if (s < S - 1) gn = *(const u32x2*)(gp + DFF);
    const f32x4 w0 = *(const f32x4*)(cw + n), w1 = *(const f32x4*)(cw + DFF + n), w2 = *(const f32x4*)(cw + 2 * DFF + n), bb = *(const f32x4*)(cb + n);
    f32x4 c, p, q;
    c[0] = bflo(g0.x); c[1] = bfhi(g0.x); c[2] = bflo(g0.y); c[3] = bfhi(g0.y);
    p[0] = bflo(gm.x); p[1] = bfhi(gm.x); p[2] = bflo(gm.y); p[3] = bfhi(gm.y);
    q[0] = bflo(gn.x); q[1] = bfhi(gn.x); q[2] = bflo(gn.y); q[3] = bfhi(gn.y);
    f32x4 o;
#pragma unroll
    for (int j = 0; j < 4; ++j) {
      const float xg = w0[j] * p[j] + w1[j] * c[j] + w2[j] * q[j] + bb[j];
      const float y = 0.7978845608028654f * (xg + 0.044715f * xg * xg * xg);
      o[j] = xg / (1.f + __expf(-2.f * y)) * v[j];
    }
    st_bf4(act + (size_t)m * DFF + n, o);
  }
};

DI bool tile_of(int r, int bid, int nb, int w, int& mt, int& n) {
  if (nb == 256) {
    if (r >= w) return false;
    const int grp = bid & 7, j = bid >> 3, L = r * 32 + j, g = L / (w * 8), rem = L - g * w * 8;
    n = rem >> 3;
    mt = grp * 32 + g * 8 + (rem & 7);
    return true;
  }
  const int total = 256 * w, per = (total + nb - 1) / nb, it = bid * per + r;
  if (r >= per || it >= total) return false;
  mt = it / w;
  n = it % w;
  return true;
}
template <bool SWAP, class Epi>
DI void gemm_phase(const bf16_t* A, int lda, const bf16_t* Bt, int ldb, int K, int ntn, int nt_lo, int nt_hi, unsigned char* lds, const Epi& epi,
                   int bid, int nb, int tid) {
  const int w = nt_hi - nt_lo;
  for (int r = 0;; ++r) {
    int mt, n;
    if (!tile_of(r, bid, nb, w, mt, n)) break;
    gemm_tile<SWAP>(A, lda, Bt, ldb, K, mt * 256, (nt_lo + n) * 256, lds, epi, tid);
  }
}

DI float row_sum8(float v) {
  v += dppf<0x141>(v);
  v += dppf<0xB1>(v);
  v += dppf<0x4E>(v);
  return v;
}
DI void scan_chain(const Params& p, int chain, unsigned char* lds, int tid) {
  const int d = chain & 1, h = (chain >> 1) & 7, b = chain >> 4;
  float* rec = (float*)lds;
  float* ybuf = (float*)(lds + 98304);
  const bf16_t* RS = (const bf16_t*)(p.ws + O_RS);
  const bf16_t* KS = (const bf16_t*)(p.ws + O_KS);
  const bf16_t* VS = (const bf16_t*)(p.ws + O_VS);
  const bf16_t* KK = (const bf16_t*)(p.ws + O_KK);
  const bf16_t* EE = (const bf16_t*)(p.ws + (d ? O_E1 : O_E0));
  const bf16_t* AA = (const bf16_t*)(p.ws + (d ? O_A1 : O_A0));
  float* Y = p.out + (size_t)d * T * 512;
  const int lane = tid & 63, wave = tid >> 6, cg = lane & 7, rg = lane >> 3, row = wave * 8 + rg;
  const float ka = p.k_a[h * 64 + lane];
  float St[8];
#pragma unroll
  for (int c = 0; c < 8; ++c) St[c] = 0.f;
  bf16_t pr[4][6];
  const int ch = h * 64 + lane;
#define SCAN_TOK(n, k) ((size_t)(b * S + (d ? (S - 1 - ((n) * 32 + (k))) : ((n) * 32 + (k)))))
#define SCAN_LOAD(n)                                                      \
  _Pragma("unroll") for (int i = 0; i < 4; ++i) {                         \
    const size_t o_ = SCAN_TOK(n, wave + 8 * i) * 512 + ch;               \
    pr[i][0] = RS[o_]; pr[i][1] = KS[o_]; pr[i][2] = VS[o_];              \
    pr[i][3] = KK[o_]; pr[i][4] = EE[o_]; pr[i][5] = AA[o_];              \
  }
#define SCAN_XFORM(buf)                                                   \
  _Pragma("unroll") for (int i = 0; i < 4; ++i) {                         \
    float* R_ = rec + (buf) * 12288 + (wave + 8 * i) * 384 + lane;        \
    const float r_ = bf2f(pr[i][0]), k_ = bf2f(pr[i][1]), v_ = bf2f(pr[i][2]), kk_ = bf2f(pr[i][3]), e_ = bf2f(pr[i][4]), a_ = bf2f(pr[i][5]); \
    R_[0] = __expf(-e_); R_[64] = kk_; R_[128] = kk_ * a_; R_[192] = k_ * (1.f + (a_ - 1.f) * ka); R_[256] = r_; R_[320] = v_; \
  }
  SCAN_LOAD(0);
  SCAN_XFORM(0);
  __syncthreads();
  for (int n = 0; n < 256; ++n) {
    if (n + 1 < 256) { SCAN_LOAD(n + 1); }
    __builtin_amdgcn_sched_barrier(0);
    const float* RB = rec + (n & 1) * 12288;
    float* YB = ybuf + (n & 1) * 2048;
#define OPS_LOAD(P, k)                                                                                              \
  {                                                                                                                 \
    const float* R_ = RB + (k) * 384 + cg * 8;                                                                      \
    P##wa = *(const f32x4*)(R_); P##wb = *(const f32x4*)(R_ + 4);                                                   \
    P##ka = *(const f32x4*)(R_ + 64); P##kb = *(const f32x4*)(R_ + 68);                                             \
    P##ba = *(const f32x4*)(R_ + 128); P##bb = *(const f32x4*)(R_ + 132);                                           \
    P##da = *(const f32x4*)(R_ + 192); P##db = *(const f32x4*)(R_ + 196);                                           \
    P##ra = *(const f32x4*)(R_ + 256); P##rb = *(const f32x4*)(R_ + 260);                                           \
    P##v = RB[(k) * 384 + 320 + row];                                                                               \
  }
#define STEP(P, k)                                                                                                  \
  {                                                                                                                 \
    float d0 = 0.f, d1 = 0.f;                                                                                       \
    _Pragma("unroll") for (int c = 0; c < 4; ++c) { d0 += St[c] * P##ka[c]; d1 += St[c + 4] * P##kb[c]; }           \
    const float dt = row_sum8(d0 + d1);                                                                             \
    float y0 = 0.f, y1 = 0.f;                                                                                       \
    _Pragma("unroll") for (int c = 0; c < 4; ++c) {                                                                 \
      St[c] = St[c] * P##wa[c] + (P##v * P##da[c] - dt * P##ba[c]);                                                 \
      St[c + 4] = St[c + 4] * P##wb[c] + (P##v * P##db[c] - dt * P##bb[c]);                                         \
      y0 += St[c] * P##ra[c];                                                                                       \
      y1 += St[c + 4] * P##rb[c];                                                                                   \
    }                                                                                                               \
    const float yy = row_sum8(y0 + y1);                                                                             \
    if (cg == 0) YB[(k) * 64 + row] = yy;                                                                           \
  }
    f32x4 Awa, Awb, Aka, Akb, Aba, Abb, Ada, Adb, Ara, Arb, Bwa, Bwb, Bka, Bkb, Bba, Bbb, Bda, Bdb, Bra, Brb;
    float Av, Bv;
    OPS_LOAD(A, 0);
#pragma unroll 2
    for (int k = 0; k < 32; k += 2) {
      OPS_LOAD(B, k + 1);
      __builtin_amdgcn_sched_barrier(0);
      STEP(A, k);
      __builtin_amdgcn_sched_barrier(0);
      if (k + 2 < 32) OPS_LOAD(A, k + 2);
      __builtin_amdgcn_sched_barrier(0);
      STEP(B, k + 1);
      __builtin_amdgcn_sched_barrier(0);
    }
#undef OPS_LOAD
#undef STEP
    if (n + 1 < 256) { SCAN_XFORM((n + 1) & 1); }
    __syncthreads();
    {
      const int k = tid >> 4, c4 = (tid & 15) * 4;
      *(f32x4*)(Y + SCAN_TOK(n, k) * 512 + h * 64 + c4) = *(const f32x4*)(YB + k * 64 + c4);
    }
  }
  __syncthreads();
#undef SCAN_TOK
#undef SCAN_LOAD
#undef SCAN_XFORM
}

constexpr int AT_K = 64 * 256, AT_V = 128 * 128, AT_STAGE = AT_K + AT_V;

DI void attn_item(const Params& p, int item, float lam, unsigned char* lds, int tid) {
  const int qb = item & 63, bh = item >> 6, h = bh & 3, b = bh >> 2;
  const int lane = tid & 63, wave = tid >> 6, fr = lane & 15, fg = lane >> 4;
  const bf16_t* QK = (const bf16_t*)(p.ws + O_QK);
  const bf16_t* VT = (const bf16_t*)(p.ws + O_VT);
  bf16_t* YC = (bf16_t*)(p.ws + O_YCAT);
  const int q0 = b * S + qb * 128 + wave * 16;
  bf16x8 qf[2][2];
#pragma unroll
  for (int c = 0; c < 2; ++c)
#pragma unroll
    for (int ks = 0; ks < 2; ++ks) qf[c][ks] = *(const bf16x8*)(QK + (size_t)(q0 + fr) * 1024 + h * 128 + c * 64 + ks * 32 + fg * 8);
  f32x4 o[2][8];
#pragma unroll
  for (int c = 0; c < 2; ++c)
#pragma unroll
    for (int i = 0; i < 8; ++i) o[c][i] = (f32x4){0.f, 0.f, 0.f, 0.f};
  f32x4 negm[2] = {(f32x4){0.f, 0.f, 0.f, 0.f}, (f32x4){0.f, 0.f, 0.f, 0.f}};
  f32x4 ol[2] = {(f32x4){0.f, 0.f, 0.f, 0.f}, (f32x4){0.f, 0.f, 0.f, 0.f}};
  const u32 onew = (fr == 0) ? 0x3F803F80u : 0u;
  const bf16x8 ones = __builtin_bit_cast(bf16x8, (u32x4){onew, onew, onew, onew});
  const int krow = tid >> 4, kkc = tid & 15;
  const int vrow = tid >> 3, vkc = tid & 7;
  const int kgc = kkc ^ ((((krow & 31) >> 3) << 2) | (krow & 3));
  const int vgc = vkc ^ ((vrow >> 1) & 7);
  const int krd = ((fr >> 2) * 8 + (fr & 3)) * 256;
  const int vrd = AT_K + fr * 128;
  const int frs = (fr >> 1) & 7;
  const bf16_t* gk = QK + (size_t)(b * S + krow) * 1024 + 512 + h * 128 + kgc * 8;
  const bf16_t* gv = VT + (size_t)((b * 4 + h) * 128 + vrow) * S + vgc * 8;
  unsigned char* lw = lds + tid * 16;
#pragma unroll
  for (int i = 0; i < 2; ++i) {
    glds16(gk + (size_t)(32 * i) * 1024, lw + i * 8192);
    glds16(gv + (size_t)(64 * i) * S, lw + AT_K + i * 8192);
  }
  WAIT_VM0();
  RAW_BAR();
  for (int kt = 0; kt < 128; ++kt) {
    if (kt + 1 < 128) {
      unsigned char* l2 = lw + ((kt + 1) & 1) * AT_STAGE;
#pragma unroll
      for (int i = 0; i < 2; ++i) {
        glds16(gk + (size_t)((kt + 1) * 64 + 32 * i) * 1024, l2 + i * 8192);
        glds16(gv + (size_t)(64 * i) * S + (kt + 1) * 64, l2 + AT_K + i * 8192);
      }
    }
    const unsigned char* sm = lds + (kt & 1) * AT_STAGE;
#define SB() __builtin_amdgcn_sched_barrier(0)
#define KFRAG(c, t4, ks) (*(const bf16x8*)(sm + krd + (((t4) >> 1) * 32 + ((t4) & 1) * 4) * 256 + ((((c) * 8 + (ks) * 4 + fg) ^ fr) * 16)))
#define VFRAG(vt, kb) (*(const bf16x8*)(sm + vrd + (vt) * 16 * 128 + ((((kb) * 4 + fg) ^ frs) * 16)))
    bf16x8 kf0[8];
#pragma unroll
    for (int i = 0; i < 8; ++i) kf0[i] = KFRAG(0, i >> 1, i & 1);
    SB();
    f32x4 s[2][4];
#pragma unroll
    for (int t4 = 0; t4 < 4; ++t4) {
      s[0][t4] = __builtin_amdgcn_mfma_f32_16x16x32_bf16(kf0[t4 * 2], qf[0][0], negm[0], 0, 0, 0);
      s[0][t4] = __builtin_amdgcn_mfma_f32_16x16x32_bf16(kf0[t4 * 2 + 1], qf[0][1], s[0][t4], 0, 0, 0);
    }
    SB();
    bf16x8 kf1[8];
#pragma unroll
    for (int i = 0; i < 8; ++i) kf1[i] = KFRAG(1, i >> 1, i & 1);
    bf16x8 va[4];
#pragma unroll
    for (int i = 0; i < 4; ++i) va[i] = VFRAG(i >> 1, i & 1);
    SB();
#pragma unroll
    for (int t4 = 0; t4 < 4; ++t4) {
      s[1][t4] = __builtin_amdgcn_mfma_f32_16x16x32_bf16(kf1[t4 * 2], qf[1][0], negm[1], 0, 0, 0);
      s[1][t4] = __builtin_amdgcn_mfma_f32_16x16x32_bf16(kf1[t4 * 2 + 1], qf[1][1], s[1][t4], 0, 0, 0);
    }
    SB();
    float mx[2];
#pragma unroll
    for (int c = 0; c < 2; ++c) {
      mx[c] = fmaxf(fmaxf(s[c][0][0], s[c][0][1]), s[c][0][2]);
      mx[c] = fmaxf(fmaxf(mx[c], s[c][0][3]), s[c][1][0]);
      mx[c] = fmaxf(fmaxf(mx[c], s[c][1][1]), s[c][1][2]);
      mx[c] = fmaxf(fmaxf(mx[c], s[c][1][3]), s[c][2][0]);
      mx[c] = fmaxf(fmaxf(mx[c], s[c][2][1]), s[c][2][2]);
      mx[c] = fmaxf(fmaxf(mx[c], s[c][2][3]), s[c][3][0]);
      mx[c] = fmaxf(fmaxf(mx[c], s[c][3][1]), s[c][3][2]);
      mx[c] = fmaxf(mx[c], s[c][3][3]);
    }
    if (kt == 0 || __any((mx[0] > 8.f) | (mx[1] > 8.f))) {
#pragma unroll
      for (int c = 0; c < 2; ++c) {
        float m2 = fmaxf(mx[c], __shfl_xor(mx[c], 16));
        m2 = fmaxf(m2, __shfl_xor(m2, 32));
        const float dl = (kt == 0) ? m2 : fmaxf(m2, 0.f);
        const float alpha = (kt == 0) ? 1.f : __builtin_amdgcn_exp2f(-dl);
        negm[c] = negm[c] - dl;
        ol[c] = ol[c] * alpha;
#pragma unroll
        for (int i = 0; i < 8; ++i) o[c][i] = o[c][i] * alpha;
#pragma unroll
        for (int t4 = 0; t4 < 4; ++t4) s[c][t4] = s[c][t4] - dl;
      }
    }
    bf16x8 pf[2][2];
#pragma unroll
    for (int c = 0; c < 2; ++c) {
#pragma unroll
      for (int t4 = 0; t4 < 4; ++t4)
#pragma unroll
        for (int j = 0; j < 4; ++j) s[c][t4][j] = __builtin_amdgcn_exp2f(s[c][t4][j]);
#pragma unroll
      for (int kb = 0; kb < 2; ++kb) {
        u32x4 w;
        w.x = pk2(s[c][2 * kb][0], s[c][2 * kb][1]);
        w.y = pk2(s[c][2 * kb][2], s[c][2 * kb][3]);
        w.z = pk2(s[c][2 * kb + 1][0], s[c][2 * kb + 1][1]);
        w.w = pk2(s[c][2 * kb + 1][2], s[c][2 * kb + 1][3]);
        pf[c][kb] = __builtin_bit_cast(bf16x8, w);
      }
    }
    SB();
#pragma unroll
    for (int c = 0; c < 2; ++c)
#pragma unroll
      for (int kb = 0; kb < 2; ++kb) ol[c] = __builtin_amdgcn_mfma_f32_16x16x32_bf16(ones, pf[c][kb], ol[c], 0, 0, 0);
    SB();
#pragma unroll
    for (int g = 0; g < 4; ++g) {
      bf16x8 vb[4];
      if (g < 3) {
#pragma unroll
        for (int i = 0; i < 4; ++i) vb[i] = VFRAG(2 * g + 2 + (i >> 1), i & 1);
      }
      SB();
#pragma unroll
      for (int i = 0; i < 4; ++i) {
        o[0][2 * g + (i >> 1)] = __builtin_amdgcn_mfma_f32_16x16x32_bf16(va[i], pf[0][i & 1], o[0][2 * g + (i >> 1)], 0, 0, 0);
        o[1][2 * g + (i >> 1)] = __builtin_amdgcn_mfma_f32_16x16x32_bf16(va[i], pf[1][i & 1], o[1][2 * g + (i >> 1)], 0, 0, 0);
      }
      SB();
      if (g < 3) {
#pragma unroll
        for (int i = 0; i < 4; ++i) va[i] = vb[i];
      }
    }
#undef SB
#undef KFRAG
#undef VFRAG
    WAIT_VM0();
    RAW_BAR();
  }
  const float l0 = __shfl(ol[0][0], fr), l1 = __shfl(ol[1][0], fr);
  const float i0 = 1.f / l0, i1 = lam / l1;
  float ss = 0.f;
#pragma unroll
  for (int vt = 0; vt < 8; ++vt) {
    o[0][vt] = o[0][vt] * i0 - o[1][vt] * i1;
#pragma unroll
    for (int j = 0; j < 4; ++j) ss += o[0][vt][j] * o[0][vt][j];
  }
  ss += __shfl_xor(ss, 16);
  ss += __shfl_xor(ss, 32);
  const float rs = rsqrtf(ss * (1.f / 128.f) + 1e-6f) * 0.8f;
#pragma unroll
  for (int vt = 0; vt < 8; ++vt) {
    const int vd = vt * 16 + fg * 4;
    const f32x4 g4 = *(const f32x4*)(p.subln + vd);
    st_bf4(YC + (size_t)(q0 + fr) * 1024 + h * 128 + vd, o[0][vt] * g4 * rs);
  }
}


#ifndef STOP
#define STOP 99
#endif
DI void digest(const Params& p, int which, int bid, int nb, int tid) {
  const unsigned char* ws = p.ws;
  for (size_t i = (size_t)bid * 512 + tid; i < (size_t)T * 1024; i += (size_t)nb * 512) {
    const size_t t = i >> 10; const int c = (int)(i & 1023);
    float v = 0.f;
    if (which == 3) {
      v = bf2f(((const bf16_t*)(ws + O_QK))[i]);
      if (c < 512) {
        const size_t o = t * 512 + c;
        v += bf2f(((const bf16_t*)(ws + O_VT))[o]) + bf2f(((const bf16_t*)(ws + O_RS))[o]) + bf2f(((const bf16_t*)(ws + O_KS))[o]) +
             bf2f(((const bf16_t*)(ws + O_VS))[o]) + bf2f(((const bf16_t*)(ws + O_KK))[o]) + bf2f(((const bf16_t*)(ws + O_E0))[o]) +
             bf2f(((const bf16_t*)(ws + O_E1))[o]) + bf2f(((const bf16_t*)(ws + O_A0))[o]) + bf2f(((const bf16_t*)(ws + O_A1))[o]) +
             bf2f(((const bf16_t*)(ws + O_GG))[o]);
      }
    } else if (which == 0) {
      v = bf2f(((const bf16_t*)(ws + O_XB))[i]) + ((const float*)(ws + O_RSTD1))[t] + bf2f(((const bf16_t*)(ws + O_WINT))[i % (size_t)(3456 * 1024)]) +
          bf2f(((const bf16_t*)(ws + O_WUPT))[i % (size_t)(5632 * 1024)]) + bf2f(((const bf16_t*)(ws + O_WDOWNT))[i % (size_t)(2816 * 1024)]) +
          bf2f(((const bf16_t*)(ws + O_WOUTT))[i % (size_t)(1024 * 1024)]) + bf2f(((const bf16_t*)(ws + O_W2T))[i % (size_t)(196608)]) +
          ((const float*)(ws + O_ROPE))[i % (size_t)(8192 * 64)];
    } else if (which == 1) {
      v = bf2f(((const bf16_t*)(ws + O_QK))[i]);
      if (c < 512) v += bf2f(((const bf16_t*)(ws + O_VT))[t * 512 + c]);
      v += bf2f(((const bf16_t*)(ws + O_Z))[t * 1920 + c]);
      if (c < 896) v += bf2f(((const bf16_t*)(ws + O_Z))[t * 1920 + 1024 + c]);
    } else if (which == 2) {
      if (c < 512) {
        const size_t o = t * 512 + c;
        v = bf2f(((const bf16_t*)(ws + O_RS))[o]) + bf2f(((const bf16_t*)(ws + O_KS))[o]) + bf2f(((const bf16_t*)(ws + O_VS))[o]) + bf2f(((const bf16_t*)(ws + O_KK))[o]);
      } else if (c < 896) v = bf2f(((const bf16_t*)(ws + O_LIN))[t * 384 + c - 512]);
    } else if (which == 6) {
      v = bf2f(((const bf16_t*)(ws + O_YCAT))[i]);
    }
    p.out[i] = v;
  }
}

__global__ void __launch_bounds__(512) mega(Params p) {
  cg::grid_group grid = cg::this_grid();
  extern __shared__ __attribute__((aligned(16))) unsigned char lds[];
  __shared__ int s_item;
  const int tid = threadIdx.x, bid = blockIdx.x, nb = gridDim.x, lane = tid & 63, wave = tid >> 6;
  const int gw = bid * 8 + wave, ngw = nb * 8;
  unsigned char* ws = p.ws;
  float* rstd1 = (float*)(ws + O_RSTD1);
  float* rstd2 = (float*)(ws + O_RSTD2);
  float* misc = (float*)(ws + O_MISC);
  unsigned* gbar = (unsigned*)(ws + O_MISC + 4096);

  {
    bf16_t* xb = (bf16_t*)(ws + O_XB);
    for (int row = gw; row < T; row += ngw) {
      const f32x4* xr = (const f32x4*)(p.x + (size_t)row * D) + lane;
      f32x4 v[4];
      float s = 0.f;
#pragma unroll
      for (int j = 0; j < 4; ++j) {
        v[j] = xr[64 * j];
        s += v[j][0] * v[j][0] + v[j][1] * v[j][1] + v[j][2] * v[j][2] + v[j][3] * v[j][3];
      }
      s = wave_sum(s);
      if (lane == 0) rstd1[row] = rsqrtf(s * (1.f / D) + 1e-6f);
      bf16_t* orow = xb + (size_t)row * D + lane * 4;
#pragma unroll
      for (int j = 0; j < 4; ++j) st_bf4(orow + 256 * j, v[j]);
    }
    float* tile = (float*)lds;
    transpose_job(p.w_in, D, NIN, (bf16_t*)(ws + O_WINT), p.pre_mix, true, tile, bid, nb, tid);
    transpose_job(p.w_out, D, D, (bf16_t*)(ws + O_WOUTT), nullptr, false, tile, bid, nb, tid);
    transpose_job(p.w_up, D, 2 * DFF, (bf16_t*)(ws + O_WUPT), p.pre_ffn, false, tile, bid, nb, tid);
    transpose_job(p.w_down, DFF, D, (bf16_t*)(ws + O_WDOWNT), nullptr, false, tile, bid, nb, tid);
    transpose_job(p.w2, 64, 512, (bf16_t*)(ws + O_W2T), nullptr, false, tile, bid, nb, tid);
    transpose_job(p.w2 + 64 * 512, 64, 512, (bf16_t*)(ws + O_W2T) + 512 * 64, nullptr, false, tile, bid, nb, tid);
    transpose_job(p.a2, 64, 512, (bf16_t*)(ws + O_A2T), nullptr, false, tile, bid, nb, tid);
    transpose_job(p.a2 + 64 * 512, 64, 512, (bf16_t*)(ws + O_A2T) + 512 * 64, nullptr, false, tile, bid, nb, tid);
    transpose_job(p.g2, 128, 512, (bf16_t*)(ws + O_G2T), nullptr, false, tile, bid, nb, tid);
    f32x2* rope = (f32x2*)(ws + O_ROPE);
    for (int i = bid * 512 + tid; i < S * 32; i += nb * 512) {
      const int s = i >> 5, f = i & 31;
      const float inv = powf(10000.f, -(float)f / 32.f);
      const float ang = (float)s * inv;
      rope[i] = (f32x2){cosf(ang), sinf(ang)};
    }
    if (bid == 0 && tid == 0) {
      float s1 = 0.f, s2 = 0.f;
      for (int i = 0; i < 64; ++i) {
        s1 += p.lq1[i] * p.lk1[i];
        s2 += p.lq2[i] * p.lk2[i];
      }
      misc[0] = expf(s1) - expf(s2) + 0.2f;
      for (int i = 0; i < 8; ++i) ((int*)misc)[16 + i * 16] = 0;
    }
  }
  grid.sync();
  if (STOP == 0) { digest(p, 0, bid, nb, tid); return; }

  {
    const bf16_t* xb = (const bf16_t*)(ws + O_XB);
    const bf16_t* wt = (const bf16_t*)(ws + O_WINT);
    EpiInProj e1{rstd1, (const f32x2*)(ws + O_ROPE), (bf16_t*)(ws + O_QK), (bf16_t*)(ws + O_Z)};
    EpiV ev{rstd1, (bf16_t*)(ws + O_VT)};
    for (int r = 0;; ++r) {
      int mt, nt;
      if (!tile_of(r, bid, nb, 14, mt, nt)) break;
      if (nt == 4 || nt == 5) gemm_tile<true>(xb, D, wt, D, D, mt * 256, nt * 256, lds, ev, tid);
      else gemm_tile<false>(xb, D, wt, D, D, mt * 256, nt * 256, lds, e1, tid);
    }
  }
  gsync(gbar, bid, nb, 1u);

  {
    const bf16_t* Z = (const bf16_t*)(ws + O_Z);
    bf16_t* RS = (bf16_t*)(ws + O_RS);
    bf16_t* KS = (bf16_t*)(ws + O_KS);
    bf16_t* VS = (bf16_t*)(ws + O_VS);
    bf16_t* KK = (bf16_t*)(ws + O_KK);
    bf16_t* LIN = (bf16_t*)(ws + O_LIN);
    for (int t = gw; t < T; t += ngw) {
      const int s = t & (S - 1);
      const bool hp = s > 0, hn = s < S - 1;
      const bf16_t* zc = Z + (size_t)t * NRW;
      u32x2 z0[8], zp[8], zn[8];
#pragma unroll
      for (int it = 0; it < 8; ++it) {
        const int c = it * 256 + lane * 4;
        const bool ok = (it < 7) || (lane < 32);
        z0[it] = ok ? *(const u32x2*)(zc + c) : (u32x2){0u, 0u};
        zp[it] = (ok && hp) ? *(const u32x2*)(zc + c - NRW) : (u32x2){0u, 0u};
        zn[it] = (ok && hn) ? *(const u32x2*)(zc + c + NRW) : (u32x2){0u, 0u};
      }
#pragma unroll
      for (int it = 0; it < 8; ++it) {
        const int c = it * 256 + lane * 4;
        const bool ok = (it < 7) || (lane < 32);
        f32x4 m4 = (f32x4){0.f, 0.f, 0.f, 0.f};
        if (ok) m4 = *(const f32x4*)(p.mu + c);
        f32x4 a, pv, nx, v;
        a[0] = bflo(z0[it].x); a[1] = bfhi(z0[it].x); a[2] = bflo(z0[it].y); a[3] = bfhi(z0[it].y);
        pv[0] = bflo(zp[it].x); pv[1] = bfhi(zp[it].x); pv[2] = bflo(zp[it].y); pv[3] = bfhi(zp[it].y);
        nx[0] = bflo(zn[it].x); nx[1] = bfhi(zn[it].x); nx[2] = bflo(zn[it].y); nx[3] = bfhi(zn[it].y);
#pragma unroll
        for (int j = 0; j < 4; ++j) v[j] = a[j] + (0.5f * (pv[j] + nx[j]) - a[j]) * m4[j];
        if (it < 2) {
          st_bf4(RS + (size_t)t * 512 + c, v);
        } else if (it < 4) {
          const int cc = c - 512;
          st_bf4(KS + (size_t)t * 512 + cc, v);
          const f32x4 kk = *(const f32x4*)(p.k_k + cc);
          f32x4 f = v * kk;
          float ss = f[0] * f[0] + f[1] * f[1] + f[2] * f[2] + f[3] * f[3];
          ss = row_sum16(ss);
          const float rn = rsqrtf(fmaxf(ss, 1e-12f));
          st_bf4(KK + (size_t)t * 512 + cc, f * rn);
        } else if (it < 6) {
          st_bf4(VS + (size_t)t * 512 + (c - 1024), v);
        } else if (it == 6) {
          f32x4 o;
          if (lane < 32) { o[0] = tanhf(v[0]); o[1] = tanhf(v[1]); o[2] = tanhf(v[2]); o[3] = tanhf(v[3]); }
          else o = v;
          st_bf4(LIN + (size_t)t * 384 + (c - 1536), o);
        } else if (lane < 32) {
          f32x4 o;
          o[0] = sigmoidf_(v[0]); o[1] = sigmoidf_(v[1]); o[2] = sigmoidf_(v[2]); o[3] = sigmoidf_(v[3]);
          st_bf4(LIN + (size_t)t * 384 + (c - 1536), o);
        }
      }
    }
  }
  gsync(gbar, bid, nb, 2u);
  if (STOP == 2) { digest(p, 2, bid, nb, tid); return; }

  {
    const bf16_t* LIN = (const bf16_t*)(ws + O_LIN);
    const bf16_t* W2T = (const bf16_t*)(ws + O_W2T);
    const bf16_t* A2T = (const bf16_t*)(ws + O_A2T);
    const bf16_t* G2T = (const bf16_t*)(ws + O_G2T);
#pragma unroll 1
    for (int job = 0; job < 5; ++job) {
      const int d = job & 1;
      const bf16_t* Aj = job < 2 ? LIN + d * 64 : (job < 4 ? LIN + 128 + d * 64 : LIN + 256);
      const bf16_t* Bj = job < 2 ? W2T + d * 512 * 64 : (job < 4 ? A2T + d * 512 * 64 : G2T);
      const int Kj = job < 4 ? 64 : 128;
      const size_t oo = job < 2 ? (d ? O_E1 : O_E0) : (job < 4 ? (d ? O_A1 : O_A0) : O_GG);
      EpiLora ej{job < 2 ? 0 : (job < 4 ? 1 : 2), job < 2 ? p.w0 + d * 512 : p.a0 + d * 512, (bf16_t*)(ws + oo)};
      gemm_phase<false>(Aj, 384, Bj, Kj, Kj, 2, 0, 2, lds, ej, bid, nb, tid);
    }
  }
  gsync(gbar, bid, nb, 3u);
  if (STOP == 3) { digest(p, 3, bid, nb, tid); return; }

  {
    const float lam = misc[0];
    const int grp = bid & 7;
    int* counter = (int*)misc + 16 + grp * 16;
    for (;;) {
      if (tid == 0) s_item = atomicAdd(counter, 1);
      __syncthreads();
      const int item = s_item;
      __syncthreads();
      if (item >= 16 + 256) break;
      if (item < 16) scan_chain(p, grp * 16 + item, lds, tid);
      else attn_item(p, grp * 256 + (item - 16), lam, lds, tid);
    }
  }
  gsync(gbar, bid, nb, 4u);

  {
    const float* Y0 = p.out;
    const float* Y1 = p.out + (size_t)T * 512;
    const bf16_t* RS = (const bf16_t*)(ws + O_RS);
    const bf16_t* KS = (const bf16_t*)(ws + O_KS);
    const bf16_t* VS = (const bf16_t*)(ws + O_VS);
    const bf16_t* A0 = (const bf16_t*)(ws + O_A0);
    const bf16_t* A1 = (const bf16_t*)(ws + O_A1);
    const bf16_t* GG = (const bf16_t*)(ws + O_GG);
    bf16_t* YC = (bf16_t*)(ws + O_YCAT);
#pragma unroll 2
    for (int idx = gw; idx < T * 2; idx += ngw) {
      const int t = idx >> 1, c = (idx & 1) * 256 + lane * 4;
      const size_t o = (size_t)t * 512 + c;
      const f32x4 ya = *(const f32x4*)(Y0 + o), yb = *(const f32x4*)(Y1 + o);
      const u32x2 rr = *(const u32x2*)(RS + o), kr = *(const u32x2*)(KS + o), vr = *(const u32x2*)(VS + o);
      const u32x2 a0r = *(const u32x2*)(A0 + o), a1r = *(const u32x2*)(A1 + o), gr = *(const u32x2*)(GG + o);
      const f32x4 gw4 = *(const f32x4*)(p.gn_w + c), gb4 = *(const f32x4*)(p.gn_b + c), ka4 = *(const f32x4*)(p.k_a + c), rk4 = *(const f32x4*)(p.r_k + c);
      const f32x4 y = ya + yb;
      const float mean = row_sum16(y[0] + y[1] + y[2] + y[3]) * (1.f / 64.f);
      const f32x4 dl = y - mean;
      const float var = row_sum16(dl[0] * dl[0] + dl[1] * dl[1] + dl[2] * dl[2] + dl[3] * dl[3]) * (1.f / 64.f);
      const float rs = rsqrtf(var + 64e-5f);
      f32x4 r, k, v, a0, a1, g;
      r[0] = bflo(rr.x); r[1] = bfhi(rr.x); r[2] = bflo(rr.y); r[3] = bfhi(rr.y);
      k[0] = bflo(kr.x); k[1] = bfhi(kr.x); k[2] = bflo(kr.y); k[3] = bfhi(kr.y);
      v[0] = bflo(vr.x); v[1] = bfhi(vr.x); v[2] = bflo(vr.y); v[3] = bfhi(vr.y);
      a0[0] = bflo(a0r.x); a0[1] = bfhi(a0r.x); a0[2] = bflo(a0r.y); a0[3] = bfhi(a0r.y);
      a1[0] = bflo(a1r.x); a1[1] = bfhi(a1r.x); a1[2] = bflo(a1r.y); a1[3] = bfhi(a1r.y);
      g[0] = bflo(gr.x); g[1] = bfhi(gr.x); g[2] = bflo(gr.y); g[3] = bfhi(gr.y);
      float bp = 0.f;
#pragma unroll
      for (int j = 0; j < 4; ++j) bp += r[j] * (k[j] * (2.f + (a0[j] + a1[j] - 2.f) * ka4[j])) * rk4[j];
      const float bs = row_sum16(bp);
      f32x4 out;
#pragma unroll
      for (int j = 0; j < 4; ++j) out[j] = (dl[j] * rs * gw4[j] + gb4[j] + bs * v[j]) * g[j];
      st_bf4(YC + (size_t)t * 1024 + 512 + c, out);
    }
  }
  gsync(gbar, bid, nb, 5u);
  if (STOP == 6) { digest(p, 6, bid, nb, tid); return; }

  {
    EpiB16 e{(bf16_t*)(ws + O_MIX), D};
    gemm_phase<false>((const bf16_t*)(ws + O_YCAT), D, (const bf16_t*)(ws + O_WOUTT), D, D, 4, 0, 4, lds, e, bid, nb, tid);
  }
  gsync(gbar, bid, nb, 6u);

  {
    const bf16_t* mix = (const bf16_t*)(ws + O_MIX);
    bf16_t* x1b = (bf16_t*)(ws + O_X1B);
    for (int row = gw; row < T; row += ngw) {
      const u32x2* mr = (const u32x2*)(mix + (size_t)row * D) + lane;
      const f32x4* xr = (const f32x4*)(p.x + (size_t)row * D) + lane;
      const f32x4* gr = (const f32x4*)(p.post_mix) + lane;
      f32x4 mv[4];
      float s = 0.f;
#pragma unroll
      for (int j = 0; j < 4; ++j) {
        { const u32x2 q_ = mr[64 * j]; mv[j][0] = bflo(q_.x); mv[j][1] = bfhi(q_.x); mv[j][2] = bflo(q_.y); mv[j][3] = bfhi(q_.y); }
        s += mv[j][0] * mv[j][0] + mv[j][1] * mv[j][1] + mv[j][2] * mv[j][2] + mv[j][3] * mv[j][3];
      }
      const float rs = rsqrtf(wave_sum(s) * (1.f / D) + 1e-6f);
      float s2 = 0.f;
      f32x4* orow = (f32x4*)(p.out + (size_t)row * D) + lane;
#pragma unroll
      for (int j = 0; j < 4; ++j) {
        mv[j] = xr[64 * j] + mv[j] * rs * gr[64 * j];
        s2 += mv[j][0] * mv[j][0] + mv[j][1] * mv[j][1] + mv[j][2] * mv[j][2] + mv[j][3] * mv[j][3];
        orow[64 * j] = mv[j];
        st_bf4(x1b + (size_t)row * D + lane * 4 + 256 * j, mv[j]);
      }
      s2 = wave_sum(s2);
      if (lane == 0) rstd2[row] = rsqrtf(s2 * (1.f / D) + 1e-6f);
    }
  }
  gsync(gbar, bid, nb, 7u);

  {
    EpiGate e{rstd2, (bf16_t*)(ws + O_G)};
    gemm_phase<false>((const bf16_t*)(ws + O_X1B), D, (const bf16_t*)(ws + O_WUPT), D, D, 11, 0, 11, lds, e, bid, nb, tid);
  }
  gsync(gbar, bid, nb, 8u);

  {
    EpiUp e{rstd2, (const bf16_t*)(ws + O_G), p.conv_w, p.conv_b, (bf16_t*)(ws + O_ACT)};
    gemm_phase<false>((const bf16_t*)(ws + O_X1B), D, (const bf16_t*)(ws + O_WUPT) + (size_t)DFF * D, D, D, 11, 0, 11, lds, e, bid, nb, tid);
  }
  gsync(gbar, bid, nb, 9u);

  {
    EpiB16 e{(bf16_t*)(ws + O_F), D};
    gemm_phase<false>((const bf16_t*)(ws + O_ACT), DFF, (const bf16_t*)(ws + O_WDOWNT), DFF, DFF, 4, 0, 4, lds, e, bid, nb, tid);
  }
  gsync(gbar, bid, nb, 10u);

  {
    const bf16_t* f = (const bf16_t*)(ws + O_F);
    for (int row = gw; row < T; row += ngw) {
      const u32x2* fr_ = (const u32x2*)(f + (size_t)row * D) + lane;
      const f32x4* gr = (const f32x4*)(p.post_ffn) + lane;
      f32x4* orow = (f32x4*)(p.out + (size_t)row * D) + lane;
      f32x4 fv[4];
      float s = 0.f;
#pragma unroll
      for (int j = 0; j < 4; ++j) {
        { const u32x2 q_ = fr_[64 * j]; fv[j][0] = bflo(q_.x); fv[j][1] = bfhi(q_.x); fv[j][2] = bflo(q_.y); fv[j][3] = bfhi(q_.y); }
        s += fv[j][0] * fv[j][0] + fv[j][1] * fv[j][1] + fv[j][2] * fv[j][2] + fv[j][3] * fv[j][3];
      }
      const float rs = rsqrtf(wave_sum(s) * (1.f / D) + 1e-6f);
#pragma unroll
      for (int j = 0; j < 4; ++j) orow[64 * j] = orow[64 * j] + fv[j] * rs * gr[64 * j];
    }
  }
}

extern "C" void kernel_launch(void* const* d_in, const int* in_sizes, int n_in, void* d_out, int out_size, void* d_ws, size_t ws_size,
                              hipStream_t stream) {
  static int grid_blocks = 0;
  if (grid_blocks == 0) {
    if (n_in != 27 || in_sizes[0] != T * D || out_size != T * D || ws_size < WS_END) {
      fprintf(stderr, "kernel_launch: unexpected shapes (n_in %d, in0 %d, out %d, ws %zu)\n", n_in, n_in > 0 ? in_sizes[0] : -1, out_size, ws_size);
      grid_blocks = -1;
      return;
    }
    int dev = 0, cus = 0, per_cu = 0;
    (void)hipGetDevice(&dev);
    (void)hipDeviceGetAttribute(&cus, hipDeviceAttributeMultiprocessorCount, dev);
    (void)hipFuncSetAttribute((const void*)mega, hipFuncAttributeMaxDynamicSharedMemorySize, LDS_BYTES);
    (void)hipOccupancyMaxActiveBlocksPerMultiprocessor(&per_cu, (const void*)mega, 512, LDS_BYTES);
    if (per_cu < 1) per_cu = 1;
    grid_blocks = cus * per_cu;
  }
  if (grid_blocks < 0) return;
  Params p{};
  const float** pp = (const float**)&p;
  for (int i = 0; i < 27; ++i) pp[i] = (const float*)d_in[i];
  p.out = (float*)d_out;
  p.ws = (unsigned char*)d_ws;
  (void)hipMemsetAsync((char*)d_ws + O_MISC + 4096, 0, 4096, stream);
  void* args[] = {&p};
  hipError_t e = hipLaunchCooperativeKernel((const void*)mega, dim3(grid_blocks), dim3(512), args, LDS_BYTES, stream);
  if (e != hipSuccess) fprintf(stderr, "cooperative launch failed: %s (grid %d)\n", hipGetErrorString(e), grid_blocks);
}
```

```cpp
#include <hip/hip_runtime.h>
#include <hip/hip_cooperative_groups.h>
#include <cstdio>
namespace cg = cooperative_groups;

typedef unsigned short bf16_t;
typedef short bf16x8 __attribute__((ext_vector_type(8)));
typedef float f32x4 __attribute__((ext_vector_type(4)));
typedef float f32x2 __attribute__((ext_vector_type(2)));
typedef unsigned int u32;
typedef u32 u32x4 __attribute__((ext_vector_type(4)));
typedef u32 u32x2 __attribute__((ext_vector_type(2)));

#define DI __device__ __forceinline__

constexpr int T = 65536, S = 8192, D = 1024, NIN = 3456, NRW = 1920, DFF = 2816;
constexpr size_t MiB = 1ull << 20;
constexpr size_t O_WINT = 0, O_WOUTT = 7 * MiB, O_WUPT = 9 * MiB, O_WDOWNT = 20 * MiB;
constexpr size_t O_W2T = 26 * MiB, O_A2T = O_W2T + 131072, O_G2T = O_W2T + 262144;
constexpr size_t O_ROPE = 27 * MiB, O_RSTD1 = 29 * MiB, O_RSTD2 = O_RSTD1 + 262144, O_MISC = 30 * MiB;
constexpr size_t O_XB = 32 * MiB, O_LIN = 32 * MiB, O_YCAT = 32 * MiB, O_ACT = 32 * MiB;
constexpr size_t O_QK = 160 * MiB, O_VT = 288 * MiB, O_MIX = 160 * MiB;
constexpr size_t O_Z = 352 * MiB, O_E0 = 352 * MiB, O_E1 = 416 * MiB, O_A0 = 480 * MiB, O_A1 = 544 * MiB, O_GG = 608 * MiB;
constexpr size_t O_RS = 672 * MiB, O_KS = 736 * MiB, O_VS = 800 * MiB, O_KK = 864 * MiB;
constexpr size_t O_X1B = 416 * MiB, O_G = 544 * MiB, O_F = 544 * MiB;
constexpr size_t WS_END = 928 * MiB;

constexpr int LDS_BYTES = 131072;
constexpr float QSCALE = 0.125f * 1.4426950408889634f;

struct Params {
  const float *x, *pre_mix, *post_mix, *pre_ffn, *post_ffn, *w_in, *lq1, *lk1, *lq2, *lk2, *subln, *mu, *w0, *w2, *a0, *a2, *g2,
      *k_k, *k_a, *r_k, *gn_w, *gn_b, *w_out, *w_up, *conv_w, *conv_b, *w_down;
  float* out;
  unsigned char* ws;
};

typedef __bf16 bf16x2_t __attribute__((ext_vector_type(2)));
DI u32 pk2(float lo, float hi) {
  f32x2 f = {lo, hi};
  bf16x2_t b = __builtin_convertvector(f, bf16x2_t);
  return __builtin_bit_cast(u32, b);
}
DI bf16_t f2bf(float f) { return (bf16_t)(pk2(f, 0.f) & 0xffffu); }
DI float bf2f(u32 h) { return __uint_as_float(h << 16); }
DI float bflo(u32 w) { return __uint_as_float(w << 16); }
DI float bfhi(u32 w) { return __uint_as_float(w & 0xffff0000u); }
DI void st_bf4(bf16_t* p, f32x4 v) {
  u32x2 o;
  o.x = pk2(v[0], v[1]);
  o.y = pk2(v[2], v[3]);
  *(u32x2*)p = o;
}
DI float wave_sum(float v) {
#pragma unroll
  for (int o = 1; o < 64; o <<= 1) v += __shfl_xor(v, o);
  return v;
}
DI float sigmoidf_(float u) { return 1.f / (1.f + __expf(-u)); }
template <int CTRL>
DI float dppf(float v) {
  return __builtin_bit_cast(float, __builtin_amdgcn_update_dpp(0, __builtin_bit_cast(int, v), CTRL, 0xF, 0xF, true));
}
DI float row_sum16(float v) {
  v += dppf<0x128>(v);
  v += dppf<0x124>(v);
  v += dppf<0x122>(v);
  v += dppf<0x121>(v);
  return v;
}


DI void gsync(unsigned* bar, unsigned target) {
  __threadfence();
  __syncthreads();
  if (threadIdx.x == 0) {
    __hip_atomic_fetch_add(bar, 1u, __ATOMIC_RELEASE, __HIP_MEMORY_SCOPE_AGENT);
    while (__hip_atomic_load(bar, __ATOMIC_RELAXED, __HIP_MEMORY_SCOPE_AGENT) < target) __builtin_amdgcn_s_sleep(2);
  }
  __syncthreads();
  __builtin_amdgcn_fence(__ATOMIC_ACQUIRE, "agent");
}

typedef __attribute__((address_space(3))) unsigned int lds_u32;
DI void glds16(const void* g, unsigned char* l) {
  __builtin_amdgcn_global_load_lds((const unsigned*)g, (lds_u32*)l, 16, 0, 0);
}
#define WAIT_VM0() asm volatile("s_waitcnt vmcnt(0)" ::: "memory")
#define RAW_BAR() __builtin_amdgcn_s_barrier()

DI void gsync(unsigned* bar, int bid, int nb, unsigned k) {
  WAIT_VM0();
  __syncthreads();
  if (threadIdx.x == 0) {
    __builtin_amdgcn_fence(__ATOMIC_RELEASE, "agent");
    WAIT_VM0();
    if ((nb & 7) == 0) {
      const unsigned gsz = (unsigned)nb >> 3;
      const unsigned old = __hip_atomic_fetch_add(bar + 64 * (1 + (bid & 7)), 1u, __ATOMIC_RELAXED, __HIP_MEMORY_SCOPE_AGENT);
      if (old == gsz * k - 1u) __hip_atomic_fetch_add(bar, 1u, __ATOMIC_RELAXED, __HIP_MEMORY_SCOPE_AGENT);
      while (__hip_atomic_load(bar, __ATOMIC_RELAXED, __HIP_MEMORY_SCOPE_AGENT) < 8u * k) __builtin_amdgcn_s_sleep(1);
    } else {
      __hip_atomic_fetch_add(bar, 1u, __ATOMIC_RELAXED, __HIP_MEMORY_SCOPE_AGENT);
      while (__hip_atomic_load(bar, __ATOMIC_RELAXED, __HIP_MEMORY_SCOPE_AGENT) < (unsigned)nb * k) __builtin_amdgcn_s_sleep(1);
    }
    __builtin_amdgcn_fence(__ATOMIC_ACQUIRE, "agent");
    WAIT_VM0();
  }
  __syncthreads();
}

DI void transpose_job(const float* src, int K, int N, bf16_t* dst, const float* g, bool perm, float* tile, int bid, int nb, int tid) {
  const int nnt = N / 64, nit = (K / 64) * nnt;
  for (int it = bid; it < nit; it += nb) {
    const int kt = it / nnt, nt = it % nnt, k0 = kt * 64, n0 = nt * 64;
#pragma unroll
    for (int i = 0; i < 8; ++i) {
      const int kk = (tid >> 6) + 8 * i, nn = tid & 63;
      float v = src[(size_t)(k0 + kk) * N + n0 + nn];
      if (g) v *= g[k0 + kk];
      tile[kk * 65 + nn] = v;
    }
    __syncthreads();
#pragma unroll
    for (int i = 0; i < 8; ++i) {
      const int nn = (tid >> 6) + 8 * i, kk = tid & 63;
      const int n = n0 + nn;
      int nd = n;
      if (perm && n < 1024) {
        const int d = n & 63;
        nd = (n & ~63) | (2 * (d & 31) + (d >> 5));
      }
      dst[(size_t)nd * K + k0 + kk] = f2bf(tile[kk * 65 + nn]);
    }
    __syncthreads();
  }
}

constexpr int G_ASTAGE = 256 * 128, G_BSTAGE = 256 * 128, G_STAGE = G_ASTAGE + G_BSTAGE;

template <bool SWAP, class Epi>
DI void gemm_tile(const bf16_t* __restrict__ A, int lda, const bf16_t* __restrict__ Bt, int ldb, int K, int m0, int n0,
                  unsigned char* lds, const Epi& epi, int tid) {
  const int lane = tid & 63, wave = tid >> 6, wm = wave >> 2, wn = wave & 3, fr = lane & 15, fg = lane >> 4;
  f32x4 acc[8][4];
#pragma unroll
  for (int i = 0; i < 8; ++i)
#pragma unroll
    for (int j = 0; j < 4; ++j) acc[i][j] = (f32x4){0.f, 0.f, 0.f, 0.f};
  const int nk = K / 64;
  const int srow = tid >> 3, skc = tid & 7;
  const int gch = skc ^ ((srow >> 1) & 7);
  const int frs = (fr >> 1) & 7;
  const bf16_t* ga = A + (size_t)(m0 + srow) * lda + gch * 8;
  const bf16_t* gb = Bt + (size_t)(n0 + srow) * ldb + gch * 8;
  unsigned char* lw = lds + tid * 16;
#pragma unroll
  for (int i = 0; i < 4; ++i) glds16(ga + (size_t)(64 * i) * lda, lw + i * 8192);
#pragma unroll
  for (int i = 0; i < 4; ++i) glds16(gb + (size_t)(64 * i) * ldb, lw + G_ASTAGE + i * 8192);
  WAIT_VM0();
  RAW_BAR();
  const int aoff = (wm * 128 + fr) * 128, boff = G_ASTAGE + (wn * 64 + fr) * 128;
  const int c0 = ((0 * 4 + fg) ^ frs) * 16, c1 = ((1 * 4 + fg) ^ frs) * 16;
#define SB() __builtin_amdgcn_sched_barrier(0)
#define MMA16(AF, KS, MB)                                                                                                          \
  _Pragma("unroll") for (int mi = 0; mi < 4; ++mi) _Pragma("unroll") for (int ni = 0; ni < 4; ++ni) {                              \
    if (SWAP) acc[(MB) + mi][ni] = __builtin_amdgcn_mfma_f32_16x16x32_bf16(AF[mi], bfr[KS][ni], acc[(MB) + mi][ni], 0, 0, 0);     \
    else acc[(MB) + mi][ni] = __builtin_amdgcn_mfma_f32_16x16x32_bf16(bfr[KS][ni], AF[mi], acc[(MB) + mi][ni], 0, 0, 0);          \
  }
  for (int kt = 0; kt < nk; ++kt) {
    if (kt + 1 < nk) {
      unsigned char* l2 = lw + ((kt + 1) & 1) * G_STAGE;
#pragma unroll
      for (int i = 0; i < 4; ++i) glds16(ga + (size_t)(64 * i) * lda + (kt + 1) * 64, l2 + i * 8192);
#pragma unroll
      for (int i = 0; i < 4; ++i) glds16(gb + (size_t)(64 * i) * ldb + (kt + 1) * 64, l2 + G_ASTAGE + i * 8192);
    }
    const unsigned char* st = lds + (kt & 1) * G_STAGE;
    bf16x8 bfr[1][4], ax[4], ay[4];
#pragma unroll
    for (int i = 0; i < 4; ++i) bfr[0][i] = *(const bf16x8*)(st + boff + i * 2048 + c0);
#pragma unroll
    for (int i = 0; i < 4; ++i) ax[i] = *(const bf16x8*)(st + aoff + i * 2048 + c0);
    SB();
#pragma unroll
    for (int i = 0; i < 4; ++i) ay[i] = *(const bf16x8*)(st + aoff + (4 + i) * 2048 + c0);
    SB();
    MMA16(ax, 0, 0);
    SB();
#pragma unroll
    for (int i = 0; i < 4; ++i) ax[i] = *(const bf16x8*)(st + aoff + i * 2048 + c1);
    SB();
    MMA16(ay, 0, 4);
    SB();
#pragma unroll
    for (int i = 0; i < 4; ++i) bfr[0][i] = *(const bf16x8*)(st + boff + i * 2048 + c1);
#pragma unroll
    for (int i = 0; i < 4; ++i) ay[i] = *(const bf16x8*)(st + aoff + (4 + i) * 2048 + c1);
    SB();
    MMA16(ax, 0, 0);
    SB();
    MMA16(ay, 0, 4);
    WAIT_VM0();
    RAW_BAR();
  }
#undef MMA16
#undef SB
#pragma unroll
  for (int mi = 0; mi < 8; ++mi)
#pragma unroll
    for (int ni = 0; ni < 4; ++ni) {
      if (SWAP) epi(m0 + wm * 128 + mi * 16 + fg * 4, n0 + wn * 64 + ni * 16 + fr, acc[mi][ni]);
      else epi(m0 + wm * 128 + mi * 16 + fr, n0 + wn * 64 + ni * 16 + fg * 4, acc[mi][ni]);
      __builtin_amdgcn_sched_barrier(0);
    }
}

struct EpiInProj {
  const float* rstd; const f32x2* rope; bf16_t* qk; bf16_t* z;
  DI void operator()(int m, int n, f32x4 v) const {
    if (n >= NIN) return;
    const float rs = rstd[m];
    v = v * rs;
    if (n < 1024) {
      const int s = m & (S - 1), i = (n & 63) >> 1;
      const f32x2 c0 = rope[s * 32 + i], c1 = rope[s * 32 + i + 1];
      float a = v[0], b = v[1];
      v[0] = a * c0.x - b * c0.y; v[1] = b * c0.x + a * c0.y;
      a = v[2]; b = v[3];
      v[2] = a * c1.x - b * c1.y; v[3] = b * c1.x + a * c1.y;
      if (n < 512) v = v * QSCALE;
      st_bf4(qk + (size_t)m * 1024 + n, v);
    } else {
      st_bf4(z + (size_t)m * NRW + (n - 1536), v);
    }
  }
};
struct EpiV {
  const float* rstd; bf16_t* vt;
  DI void operator()(int m, int n, f32x4 v) const {
    const f32x4 rs = *(const f32x4*)(rstd + m);
    v = v * rs;
    const int nn = n - 1024, h = nn >> 7, vd = nn & 127, b = m >> 13, s = m & (S - 1);
    st_bf4(vt + ((size_t)((b * 4 + h) * 128 + vd)) * S + s, v);
  }
};
struct EpiLora {
  int mode; const float* bias; bf16_t* out;
  DI void operator()(int m, int n, f32x4 v) const {
    if (mode < 2) {
      const f32x4 bv = *(const f32x4*)(bias + n);
      const float sc = mode == 0 ? 0.60653065971f : 1.f;
#pragma unroll
      for (int j = 0; j < 4; ++j) v[j] = sc * sigmoidf_(v[j] + bv[j]);
    }
    st_bf4(out + (size_t)m * 512 + n, v);
  }
};
struct EpiB16 {
  bf16_t* out; int ld;
  DI void operator()(int m, int n, f32x4 v) const { st_bf4(out + (size_t)m * ld + n, v); }
};
struct EpiF32 {
  float* out; int ld;
  DI void operator()(int m, int n, f32x4 v) const { *(f32x4*)(out + (size_t)m * ld + n) = v; }
};
struct EpiGate {
  const float* rstd; bf16_t* g;
  DI void operator()(int m, int n, f32x4 v) const { st_bf4(g + (size_t)m * DFF + n, v * rstd[m]); }
};
struct EpiUp {
  const float* rstd; const bf16_t* g; const float* cw; const float* cb; bf16_t* act;
  DI void operator()(int m, int n, f32x4 v) const {
    v = v * rstd[m];
    const int s = m & (S - 1);
    const bf16_t* gp = g + (size_t)m * DFF + n;
    const u32x2 g0 = *(const u32x2*)gp;
    u32x2 gm = (u32x2){0u, 0u}, gn = (u32x2){0u, 0u};
    if (s > 0) gm = *(const u32x2*)(gp - DFF);
    if (s < S - 1) gn = *(const u32x2*)(gp + DFF);
    const f32x4 w0 = *(const f32x4*)(cw + n), w1 = *(const f32x4*)(cw + DFF + n), w2 = *(const f32x4*)(cw + 2 * DFF + n), bb = *(const f32x4*)(cb + n);
    f32x4 c, p, q;
    c[0] = bflo(g0.x); c[1] = bfhi(g0.x); c[2] = bflo(g0.y); c[3] = bfhi(g0.y);
    p[0] = bflo(gm.x); p[1] = bfhi(gm.x); p[2] = bflo(gm.y); p[3] = bfhi(gm.y);
    q[0] = bflo(gn.x); q[1] = bfhi(gn.x); q[2] = bflo(gn.y); q[3] = bfhi(gn.y);
    f32x4 o;
#pragma unroll
    for (int j = 0; j < 4; ++j) {
      const float xg = w0[j] * p[j] + w1[j] * c[j] + w2[j] * q[j] + bb[j];
      const float e = __builtin_amdgcn_exp2f(xg * (-2.3022082f - 0.10294324f * xg * xg));
      o[j] = xg * __builtin_amdgcn_rcpf(1.f + e) * v[j];
    }
    st_bf4(act + (size_t)m * DFF + n, o);
  }
};

DI bool tile_of(int r, int bid, int nb, int w, int& mt, int& n) {
  if (nb == 256) {
    if (r >= w) return false;
    const int grp = bid & 7, j = bid >> 3, L = r * 32 + j, g = L / (w * 8), rem = L - g * w * 8;
    n = rem >> 3;
    mt = grp * 32 + g * 8 + (rem & 7);
    return true;
  }
  const int total = 256 * w, per = (total + nb - 1) / nb, it = bid * per + r;
  if (r >= per || it >= total) return false;
  mt = it / w;
  n = it % w;
  return true;
}
template <bool SWAP, class Epi>
DI void gemm_phase(const bf16_t* A, int lda, const bf16_t* Bt, int ldb, int K, int ntn, int nt_lo, int nt_hi, unsigned char* lds, const Epi& epi,
                   int bid, int nb, int tid) {
  const int w = nt_hi - nt_lo;
  for (int r = 0;; ++r) {
    int mt, n;
    if (!tile_of(r, bid, nb, w, mt, n)) break;
    gemm_tile<SWAP>(A, lda, Bt, ldb, K, mt * 256, (nt_lo + n) * 256, lds, epi, tid);
  }
}

DI float row_sum8(float v) {
  v += dppf<0x141>(v);
  v += dppf<0xB1>(v);
  v += dppf<0x4E>(v);
  return v;
}
DI void scan_chain(const Params& p, int chain, unsigned char* lds, int tid) {
  const int d = chain & 1, h = (chain >> 1) & 7, b = chain >> 4;
  float* rec = (float*)lds;
  float* ybuf = (float*)(lds + 98304);
  const bf16_t* RS = (const bf16_t*)(p.ws + O_RS);
  const bf16_t* KS = (const bf16_t*)(p.ws + O_KS);
  const bf16_t* VS = (const bf16_t*)(p.ws + O_VS);
  const bf16_t* KK = (const bf16_t*)(p.ws + O_KK);
  const bf16_t* EE = (const bf16_t*)(p.ws + (d ? O_E1 : O_E0));
  const bf16_t* AA = (const bf16_t*)(p.ws + (d ? O_A1 : O_A0));
  float* Y = p.out + (size_t)d * T * 512;
  const int lane = tid & 63, wave = tid >> 6, cg = lane & 7, rg = lane >> 3, row = wave * 8 + rg;
  const float ka = p.k_a[h * 64 + lane];
  f32x2 St2[4];
#pragma unroll
  for (int c = 0; c < 4; ++c) St2[c] = (f32x2){0.f, 0.f};
  bf16_t pr[4][6];
  const int ch = h * 64 + lane;
#define SCAN_TOK(n, k) ((size_t)(b * S + (d ? (S - 1 - ((n) * 32 + (k))) : ((n) * 32 + (k)))))
#define SCAN_LOAD(n)                                                      \
  _Pragma("unroll") for (int i = 0; i < 4; ++i) {                         \
    const size_t o_ = SCAN_TOK(n, wave + 8 * i) * 512 + ch;               \
    pr[i][0] = RS[o_]; pr[i][1] = KS[o_]; pr[i][2] = VS[o_];              \
    pr[i][3] = KK[o_]; pr[i][4] = EE[o_]; pr[i][5] = AA[o_];              \
  }
#define SCAN_XFORM(buf)                                                   \
  _Pragma("unroll") for (int i = 0; i < 4; ++i) {                         \
    float* R_ = rec + (buf) * 12288 + (wave + 8 * i) * 384 + lane;        \
    const float r_ = bf2f(pr[i][0]), k_ = bf2f(pr[i][1]), v_ = bf2f(pr[i][2]), kk_ = bf2f(pr[i][3]), e_ = bf2f(pr[i][4]), a_ = bf2f(pr[i][5]); \
    R_[0] = __expf(-e_); R_[64] = kk_; R_[128] = kk_ * a_; R_[192] = k_ * (1.f + (a_ - 1.f) * ka); R_[256] = r_; R_[320] = v_; \
  }
  SCAN_LOAD(0);
  SCAN_XFORM(0);
  __syncthreads();
  for (int n = 0; n < 256; ++n) {
    if (n + 1 < 256) { SCAN_LOAD(n + 1); }
    __builtin_amdgcn_sched_barrier(0);
    const float* RB = rec + (n & 1) * 12288;
    float* YB = ybuf + (n & 1) * 2048;
#define OPS_LOAD(P, k)                                                                                              \
  {                                                                                                                 \
    const float* R_ = RB + (k) * 384 + cg * 8;                                                                      \
    P##wa = *(const f32x4*)(R_); P##wb = *(const f32x4*)(R_ + 4);                                                   \
    P##ka = *(const f32x4*)(R_ + 64); P##kb = *(const f32x4*)(R_ + 68);                                             \
    P##ba = *(const f32x4*)(R_ + 128); P##bb = *(const f32x4*)(R_ + 132);                                           \
    P##da = *(const f32x4*)(R_ + 192); P##db = *(const f32x4*)(R_ + 196);                                           \
    P##ra = *(const f32x4*)(R_ + 256); P##rb = *(const f32x4*)(R_ + 260);                                           \
    P##v = RB[(k) * 384 + 320 + row];                                                                               \
  }
#define LO2(V) (__builtin_shufflevector(V, V, 0, 1))
#define HI2(V) (__builtin_shufflevector(V, V, 2, 3))
#define STEP(P, k)                                                                                                  \
  {     \
    f32x2 dd = St2[0] * LO2(P##ka), de = St2[1] * HI2(P##ka);                            \
    dd = __builtin_elementwise_fma(St2[2], LO2(P##kb), dd);                                                         \
    de = __builtin_elementwise_fma(St2[3], HI2(P##kb), de);                                                         \
    dd = dd + de;                                                                                                   \
    const float dt = row_sum8(dd.x + dd.y);                                                                         \
    const f32x2 vv = (f32x2){P##v, P##v}, nd = (f32x2){-dt, -dt};                                                   \
    St2[0] = __builtin_elementwise_fma(St2[0], LO2(P##wa), __builtin_elementwise_fma(nd, LO2(P##ba), vv * LO2(P##da))); \
    St2[1] = __builtin_elementwise_fma(St2[1], HI2(P##wa), __builtin_elementwise_fma(nd, HI2(P##ba), vv * HI2(P##da))); \
    St2[2] = __builtin_elementwise_fma(St2[2], LO2(P##wb), __builtin_elementwise_fma(nd, LO2(P##bb), vv * LO2(P##db))); \
    St2[3] = __builtin_elementwise_fma(St2[3], HI2(P##wb), __builtin_elementwise_fma(nd, HI2(P##bb), vv * HI2(P##db))); \
    f32x2 yy2 = St2[0] * LO2(P##ra), yy3 = St2[1] * HI2(P##ra);                                                     \
    yy2 = __builtin_elementwise_fma(St2[2], LO2(P##rb), yy2);                                                       \
    yy3 = __builtin_elementwise_fma(St2[3], HI2(P##rb), yy3);                                                       \
    yy2 = yy2 + yy3;                                                                                                \
    const float yy = row_sum8(yy2.x + yy2.y);                                                                       \
    if (cg == 0) YB[(k) * 64 + row] = yy;                                                                           \
  }
    f32x4 Awa, Awb, Aka, Akb, Aba, Abb, Ada, Adb, Ara, Arb, Bwa, Bwb, Bka, Bkb, Bba, Bbb, Bda, Bdb, Bra, Brb;
    float Av, Bv;
    OPS_LOAD(A, 0);
#pragma unroll 2
    for (int k = 0; k < 32; k += 2) {
      OPS_LOAD(B, k + 1);
      __builtin_amdgcn_sched_barrier(0);
      STEP(A, k);
      __builtin_amdgcn_sched_barrier(0);
      if (k + 2 < 32) OPS_LOAD(A, k + 2);
      __builtin_amdgcn_sched_barrier(0);
      STEP(B, k + 1);
      __builtin_amdgcn_sched_barrier(0);
    }
#undef OPS_LOAD
#undef STEP
#undef LO2
#undef HI2
    if (n + 1 < 256) { SCAN_XFORM((n + 1) & 1); }
    __syncthreads();
    {
      const int k = tid >> 4, c4 = (tid & 15) * 4;
      *(f32x4*)(Y + SCAN_TOK(n, k) * 512 + h * 64 + c4) = *(const f32x4*)(YB + k * 64 + c4);
    }
  }
  __syncthreads();
#undef SCAN_TOK
#undef SCAN_LOAD
#undef SCAN_XFORM
}

constexpr int AT_K = 64 * 256, AT_V = 128 * 128, AT_STAGE = AT_K + AT_V;

DI void attn_item(const Params& p, int item, float lam, unsigned char* lds, int tid) {
  const int qb = item & 63, bh = item >> 6, h = bh & 3, b = bh >> 2;
  const int lane = tid & 63, wave = tid >> 6, fr = lane & 15, fg = lane >> 4;
  const bf16_t* QK = (const bf16_t*)(p.ws + O_QK);
  const bf16_t* VT = (const bf16_t*)(p.ws + O_VT);
  bf16_t* YC = (bf16_t*)(p.ws + O_YCAT);
  const int q0 = b * S + qb * 128 + wave * 16;
  bf16x8 qf[2][2];
#pragma unroll
  for (int c = 0; c < 2; ++c)
#pragma unroll
    for (int ks = 0; ks < 2; ++ks) qf[c][ks] = *(const bf16x8*)(QK + (size_t)(q0 + fr) * 1024 + h * 128 + c * 64 + ks * 32 + fg * 8);
  f32x4 o[2][8];
#pragma unroll
  for (int c = 0; c < 2; ++c)
#pragma unroll
    for (int i = 0; i < 8; ++i) o[c][i] = (f32x4){0.f, 0.f, 0.f, 0.f};
  f32x4 negm[2] = {(f32x4){0.f, 0.f, 0.f, 0.f}, (f32x4){0.f, 0.f, 0.f, 0.f}};
  f32x4 ol[2] = {(f32x4){0.f, 0.f, 0.f, 0.f}, (f32x4){0.f, 0.f, 0.f, 0.f}};
  const u32 onew = (fr == 0) ? 0x3F803F80u : 0u;
  const bf16x8 ones = __builtin_bit_cast(bf16x8, (u32x4){onew, onew, onew, onew});
  const int krow = tid >> 4, kkc = tid & 15;
  const int vrow = tid >> 3, vkc = tid & 7;
  const int kgc = kkc ^ ((((krow & 31) >> 3) << 2) | (krow & 3));
  const int vgc = vkc ^ ((vrow >> 1) & 7);
  const int krd = ((fr >> 2) * 8 + (fr & 3)) * 256;
  const int vrd = AT_K + fr * 128;
  const int frs = (fr >> 1) & 7;
  const bf16_t* gk = QK + (size_t)(b * S + krow) * 1024 + 512 + h * 128 + kgc * 8;
  const bf16_t* gv = VT + (size_t)((b * 4 + h) * 128 + vrow) * S + vgc * 8;
  unsigned char* lw = lds + tid * 16;
#pragma unroll
  for (int i = 0; i < 2; ++i) {
    glds16(gk + (size_t)(32 * i) * 1024, lw + i * 8192);
    glds16(gv + (size_t)(64 * i) * S, lw + AT_K + i * 8192);
  }
  WAIT_VM0();
  RAW_BAR();
  for (int kt = 0; kt < 128; ++kt) {
    if (kt + 1 < 128) {
      unsigned char* l2 = lw + ((kt + 1) & 1) * AT_STAGE;
#pragma unroll
      for (int i = 0; i < 2; ++i) {
        glds16(gk + (size_t)((kt + 1) * 64 + 32 * i) * 1024, l2 + i * 8192);
        glds16(gv + (size_t)(64 * i) * S + (kt + 1) * 64, l2 + AT_K + i * 8192);
      }
    }
    const unsigned char* sm = lds + (kt & 1) * AT_STAGE;
#define SB() __builtin_amdgcn_sched_barrier(0)
#define KFRAG(c, t4, ks) (*(const bf16x8*)(sm + krd + (((t4) >> 1) * 32 + ((t4) & 1) * 4) * 256 + ((((c) * 8 + (ks) * 4 + fg) ^ fr) * 16)))
#define VFRAG(vt, kb) (*(const bf16x8*)(sm + vrd + (vt) * 16 * 128 + ((((kb) * 4 + fg) ^ frs) * 16)))
    bf16x8 kf0[8];
#pragma unroll
    for (int i = 0; i < 8; ++i) kf0[i] = KFRAG(0, i >> 1, i & 1);
    SB();
    f32x4 s[2][4];
#pragma unroll
    for (int t4 = 0; t4 < 4; ++t4) {
      s[0][t4] = __builtin_amdgcn_mfma_f32_16x16x32_bf16(kf0[t4 * 2], qf[0][0], negm[0], 0, 0, 0);
      s[0][t4] = __builtin_amdgcn_mfma_f32_16x16x32_bf16(kf0[t4 * 2 + 1], qf[0][1], s[0][t4], 0, 0, 0);
    }
    SB();
    bf16x8 kf1[8];
#pragma unroll
    for (int i = 0; i < 8; ++i) kf1[i] = KFRAG(1, i >> 1, i & 1);
    bf16x8 va[4];
#pragma unroll
    for (int i = 0; i < 4; ++i) va[i] = VFRAG(i >> 1, i & 1);
    SB();
#pragma unroll
    for (int t4 = 0; t4 < 4; ++t4) {
      s[1][t4] = __builtin_amdgcn_mfma_f32_16x16x32_bf16(kf1[t4 * 2], qf[1][0], negm[1], 0, 0, 0);
      s[1][t4] = __builtin_amdgcn_mfma_f32_16x16x32_bf16(kf1[t4 * 2 + 1], qf[1][1], s[1][t4], 0, 0, 0);
    }
    SB();
    float mx[2];
#pragma unroll
    for (int c = 0; c < 2; ++c) {
      mx[c] = fmaxf(fmaxf(s[c][0][0], s[c][0][1]), s[c][0][2]);
      mx[c] = fmaxf(fmaxf(mx[c], s[c][0][3]), s[c][1][0]);
      mx[c] = fmaxf(fmaxf(mx[c], s[c][1][1]), s[c][1][2]);
      mx[c] = fmaxf(fmaxf(mx[c], s[c][1][3]), s[c][2][0]);
      mx[c] = fmaxf(fmaxf(mx[c], s[c][2][1]), s[c][2][2]);
      mx[c] = fmaxf(fmaxf(mx[c], s[c][2][3]), s[c][3][0]);
      mx[c] = fmaxf(fmaxf(mx[c], s[c][3][1]), s[c][3][2]);
      mx[c] = fmaxf(mx[c], s[c][3][3]);
    }
    if (kt == 0 || __any((mx[0] > 8.f) | (mx[1] > 8.f))) {
#pragma unroll
      for (int c = 0; c < 2; ++c) {
        float m2 = fmaxf(mx[c], __shfl_xor(mx[c], 16));
        m2 = fmaxf(m2, __shfl_xor(m2, 32));
        const float dl = (kt == 0) ? m2 : fmaxf(m2, 0.f);
        const float alpha = (kt == 0) ? 1.f : __builtin_amdgcn_exp2f(-dl);
        negm[c] = negm[c] - dl;
        ol[c] = ol[c] * alpha;
#pragma unroll
        for (int i = 0; i < 8; ++i) o[c][i] = o[c][i] * alpha;
#pragma unroll
        for (int t4 = 0; t4 < 4; ++t4) s[c][t4] = s[c][t4] - dl;
      }
    }
    bf16x8 pf[2][2];
#pragma unroll
    for (int c = 0; c < 2; ++c) {
#pragma unroll
      for (int t4 = 0; t4 < 4; ++t4)
#pragma unroll
        for (int j = 0; j < 4; ++j) s[c][t4][j] = __builtin_amdgcn_exp2f(s[c][t4][j]);
#pragma unroll
      for (int kb = 0; kb < 2; ++kb) {
        u32x4 w;
        w.x = pk2(s[c][2 * kb][0], s[c][2 * kb][1]);
        w.y = pk2(s[c][2 * kb][2], s[c][2 * kb][3]);
        w.z = pk2(s[c][2 * kb + 1][0], s[c][2 * kb + 1][1]);
        w.w = pk2(s[c][2 * kb + 1][2], s[c][2 * kb + 1][3]);
        pf[c][kb] = __builtin_bit_cast(bf16x8, w);
      }
    }
    SB();
#pragma unroll
    for (int c = 0; c < 2; ++c)
#pragma unroll
      for (int kb = 0; kb < 2; ++kb) ol[c] = __builtin_amdgcn_mfma_f32_16x16x32_bf16(ones, pf[c][kb], ol[c], 0, 0, 0);
    SB();
    __builtin_amdgcn_s_setprio(1);
#pragma unroll
    for (int g = 0; g < 4; ++g) {
      bf16x8 vb[4];
      if (g < 3) {
#pragma unroll
        for (int i = 0; i < 4; ++i) vb[i] = VFRAG(2 * g + 2 + (i >> 1), i & 1);
      }
      SB();
#pragma unroll
      for (int i = 0; i < 4; ++i) {
        o[0][2 * g + (i >> 1)] = __builtin_amdgcn_mfma_f32_16x16x32_bf16(va[i], pf[0][i & 1], o[0][2 * g + (i >> 1)], 0, 0, 0);
        o[1][2 * g + (i >> 1)] = __builtin_amdgcn_mfma_f32_16x16x32_bf16(va[i], pf[1][i & 1], o[1][2 * g + (i >> 1)], 0, 0, 0);
      }
      SB();
      if (g < 3) {
#pragma unroll
        for (int i = 0; i < 4; ++i) va[i] = vb[i];
      }
    }
    __builtin_amdgcn_s_setprio(0);
#undef SB
#undef KFRAG
#undef VFRAG
    WAIT_VM0();
    RAW_BAR();
  }
  const float l0 = __shfl(ol[0][0], fr), l1 = __shfl(ol[1][0], fr);
  const float i0 = 1.f / l0, i1 = lam / l1;
  float ss = 0.f;
#pragma unroll
  for (int vt = 0; vt < 8; ++vt) {
    o[0][vt] = o[0][vt] * i0 - o[1][vt] * i1;
#pragma unroll
    for (int j = 0; j < 4; ++j) ss += o[0][vt][j] * o[0][vt][j];
  }
  ss += __shfl_xor(ss, 16);
  ss += __shfl_xor(ss, 32);
  const float rs = rsqrtf(ss * (1.f / 128.f) + 1e-6f) * 0.8f;
#pragma unroll
  for (int vt = 0; vt < 8; ++vt) {
    const int vd = vt * 16 + fg * 4;
    const f32x4 g4 = *(const f32x4*)(p.subln + vd);
    st_bf4(YC + (size_t)(q0 + fr) * 1024 + h * 128 + vd, o[0][vt] * g4 * rs);
  }
}


__global__ void __launch_bounds__(512) mega(Params p) {
  cg::grid_group grid = cg::this_grid();
  extern __shared__ __attribute__((aligned(16))) unsigned char lds[];
  __shared__ int s_item;
  const int tid = threadIdx.x, bid = blockIdx.x, nb = gridDim.x, lane = tid & 63, wave = tid >> 6;
  const int gw = bid * 8 + wave, ngw = nb * 8;
  unsigned char* ws = p.ws;
  float* rstd1 = (float*)(ws + O_RSTD1);
  float* rstd2 = (float*)(ws + O_RSTD2);
  float* misc = (float*)(ws + O_MISC);
  unsigned* gbar = (unsigned*)(ws + O_MISC + 4096);

  {
    bf16_t* xb = (bf16_t*)(ws + O_XB);
    for (int row = gw; row < T; row += ngw) {
      const f32x4* xr = (const f32x4*)(p.x + (size_t)row * D) + lane;
      f32x4 v[4];
      float s = 0.f;
#pragma unroll
      for (int j = 0; j < 4; ++j) {
        v[j] = xr[64 * j];
        s += v[j][0] * v[j][0] + v[j][1] * v[j][1] + v[j][2] * v[j][2] + v[j][3] * v[j][3];
      }
      s = wave_sum(s);
      if (lane == 0) rstd1[row] = rsqrtf(s * (1.f / D) + 1e-6f);
      bf16_t* orow = xb + (size_t)row * D + lane * 4;
#pragma unroll
      for (int j = 0; j < 4; ++j) st_bf4(orow + 256 * j, v[j]);
    }
    float* tile = (float*)lds;
    transpose_job(p.w_in, D, NIN, (bf16_t*)(ws + O_WINT), p.pre_mix, true, tile, bid, nb, tid);
    transpose_job(p.w_out, D, D, (bf16_t*)(ws + O_WOUTT), nullptr, false, tile, bid, nb, tid);
    transpose_job(p.w_up, D, 2 * DFF, (bf16_t*)(ws + O_WUPT), p.pre_ffn, false, tile, bid, nb, tid);
    transpose_job(p.w_down, DFF, D, (bf16_t*)(ws + O_WDOWNT), nullptr, false, tile, bid, nb, tid);
    transpose_job(p.w2, 64, 512, (bf16_t*)(ws + O_W2T), nullptr, false, tile, bid, nb, tid);
    transpose_job(p.w2 + 64 * 512, 64, 512, (bf16_t*)(ws + O_W2T) + 512 * 64, nullptr, false, tile, bid, nb, tid);
    transpose_job(p.a2, 64, 512, (bf16_t*)(ws + O_A2T), nullptr, false, tile, bid, nb, tid);
    transpose_job(p.a2 + 64 * 512, 64, 512, (bf16_t*)(ws + O_A2T) + 512 * 64, nullptr, false, tile, bid, nb, tid);
    transpose_job(p.g2, 128, 512, (bf16_t*)(ws + O_G2T), nullptr, false, tile, bid, nb, tid);
    f32x2* rope = (f32x2*)(ws + O_ROPE);
    for (int i = bid * 512 + tid; i < S * 32; i += nb * 512) {
      const int s = i >> 5, f = i & 31;
      const float inv = powf(10000.f, -(float)f / 32.f);
      const float ang = (float)s * inv;
      rope[i] = (f32x2){cosf(ang), sinf(ang)};
    }
    if (bid == 0 && tid == 0) {
      float s1 = 0.f, s2 = 0.f;
      for (int i = 0; i < 64; ++i) {
        s1 += p.lq1[i] * p.lk1[i];
        s2 += p.lq2[i] * p.lk2[i];
      }
      misc[0] = expf(s1) - expf(s2) + 0.2f;
      for (int i = 0; i < 8; ++i) ((int*)misc)[16 + i * 16] = 0;
    }
  }
  grid.sync();

  {
    const bf16_t* xb = (const bf16_t*)(ws + O_XB);
    const bf16_t* wt = (const bf16_t*)(ws + O_WINT);
    EpiInProj e1{rstd1, (const f32x2*)(ws + O_ROPE), (bf16_t*)(ws + O_QK), (bf16_t*)(ws + O_Z)};
    EpiV ev{rstd1, (bf16_t*)(ws + O_VT)};
    for (int r = 0;; ++r) {
      int mt, nt;
      if (!tile_of(r, bid, nb, 14, mt, nt)) break;
      if (nt == 4 || nt == 5) gemm_tile<true>(xb, D, wt, D, D, mt * 256, nt * 256, lds, ev, tid);
      else gemm_tile<false>(xb, D, wt, D, D, mt * 256, nt * 256, lds, e1, tid);
    }
  }
  gsync(gbar, bid, nb, 1u);

  {
    const bf16_t* Z = (const bf16_t*)(ws + O_Z);
    bf16_t* RS = (bf16_t*)(ws + O_RS);
    bf16_t* KS = (bf16_t*)(ws + O_KS);
    bf16_t* VS = (bf16_t*)(ws + O_VS);
    bf16_t* KK = (bf16_t*)(ws + O_KK);
    bf16_t* LIN = (bf16_t*)(ws + O_LIN);
    for (int t = gw; t < T; t += ngw) {
      const int s = t & (S - 1);
      const bool hp = s > 0, hn = s < S - 1;
      const bf16_t* zc = Z + (size_t)t * NRW;
      u32x2 z0[8], zp[8], zn[8];
#pragma unroll
      for (int it = 0; it < 8; ++it) {
        const int c = it * 256 + lane * 4;
        const bool ok = (it < 7) || (lane < 32);
        z0[it] = ok ? *(const u32x2*)(zc + c) : (u32x2){0u, 0u};
        zp[it] = (ok && hp) ? *(const u32x2*)(zc + c - NRW) : (u32x2){0u, 0u};
        zn[it] = (ok && hn) ? *(const u32x2*)(zc + c + NRW) : (u32x2){0u, 0u};
      }
#pragma unroll
      for (int it = 0; it < 8; ++it) {
        const int c = it * 256 + lane * 4;
        const bool ok = (it < 7) || (lane < 32);
        f32x4 m4 = (f32x4){0.f, 0.f, 0.f, 0.f};
        if (ok) m4 = *(const f32x4*)(p.mu + c);
        f32x4 a, pv, nx, v;
        a[0] = bflo(z0[it].x); a[1] = bfhi(z0[it].x); a[2] = bflo(z0[it].y); a[3] = bfhi(z0[it].y);
        pv[0] = bflo(zp[it].x); pv[1] = bfhi(zp[it].x); pv[2] = bflo(zp[it].y); pv[3] = bfhi(zp[it].y);
        nx[0] = bflo(zn[it].x); nx[1] = bfhi(zn[it].x); nx[2] = bflo(zn[it].y); nx[3] = bfhi(zn[it].y);
#pragma unroll
        for (int j = 0; j < 4; ++j) v[j] = a[j] + (0.5f * (pv[j] + nx[j]) - a[j]) * m4[j];
        if (it < 2) {
          st_bf4(RS + (size_t)t * 512 + c, v);
        } else if (it < 4) {
          const int cc = c - 512;
          st_bf4(KS + (size_t)t * 512 + cc, v);
          const f32x4 kk = *(const f32x4*)(p.k_k + cc);
          f32x4 f = v * kk;
          float ss = f[0] * f[0] + f[1] * f[1] + f[2] * f[2] + f[3] * f[3];
          ss = row_sum16(ss);
          const float rn = rsqrtf(fmaxf(ss, 1e-12f));
          st_bf4(KK + (size_t)t * 512 + cc, f * rn);
        } else if (it < 6) {
          st_bf4(VS + (size_t)t * 512 + (c - 1024), v);
        } else if (it == 6) {
          f32x4 o;
          if (lane < 32) { o[0] = tanhf(v[0]); o[1] = tanhf(v[1]); o[2] = tanhf(v[2]); o[3] = tanhf(v[3]); }
          else o = v;
          st_bf4(LIN + (size_t)t * 384 + (c - 1536), o);
        } else if (lane < 32) {
          f32x4 o;
          o[0] = sigmoidf_(v[0]); o[1] = sigmoidf_(v[1]); o[2] = sigmoidf_(v[2]); o[3] = sigmoidf_(v[3]);
          st_bf4(LIN + (size_t)t * 384 + (c - 1536), o);
        }
      }
    }
  }
  gsync(gbar, bid, nb, 2u);

  {
    const bf16_t* LIN = (const bf16_t*)(ws + O_LIN);
    const bf16_t* W2T = (const bf16_t*)(ws + O_W2T);
    const bf16_t* A2T = (const bf16_t*)(ws + O_A2T);
    const bf16_t* G2T = (const bf16_t*)(ws + O_G2T);
#pragma unroll 1
    for (int job = 0; job < 5; ++job) {
      const int d = job & 1;
      const bf16_t* Aj = job < 2 ? LIN + d * 64 : (job < 4 ? LIN + 128 + d * 64 : LIN + 256);
      const bf16_t* Bj = job < 2 ? W2T + d * 512 * 64 : (job < 4 ? A2T + d * 512 * 64 : G2T);
      const int Kj = job < 4 ? 64 : 128;
      const size_t oo = job < 2 ? (d ? O_E1 : O_E0) : (job < 4 ? (d ? O_A1 : O_A0) : O_GG);
      EpiLora ej{job < 2 ? 0 : (job < 4 ? 1 : 2), job < 2 ? p.w0 + d * 512 : p.a0 + d * 512, (bf16_t*)(ws + oo)};
      gemm_phase<false>(Aj, 384, Bj, Kj, Kj, 2, 0, 2, lds, ej, bid, nb, tid);
    }
  }
  gsync(gbar, bid, nb, 3u);

  {
    const float lam = misc[0];
    const int grp = bid & 7;
    int* counter = (int*)misc + 16 + grp * 16;
    for (;;) {
      if (tid == 0) s_item = atomicAdd(counter, 1);
      __syncthreads();
      const int item = s_item;
      __syncthreads();
      if (item >= 16 + 256) break;
      if (item < 16) scan_chain(p, grp * 16 + item, lds, tid);
      else attn_item(p, grp * 256 + (item - 16), lam, lds, tid);
    }
  }
  gsync(gbar, bid, nb, 4u);

  {
    const float* Y0 = p.out;
    const float* Y1 = p.out + (size_t)T * 512;
    const bf16_t* RS = (const bf16_t*)(ws + O_RS);
    const bf16_t* KS = (const bf16_t*)(ws + O_KS);
    const bf16_t* VS = (const bf16_t*)(ws + O_VS);
    const bf16_t* A0 = (const bf16_t*)(ws + O_A0);
    const bf16_t* A1 = (const bf16_t*)(ws + O_A1);
    const bf16_t* GG = (const bf16_t*)(ws + O_GG);
    bf16_t* YC = (bf16_t*)(ws + O_YCAT);
#pragma unroll 2
    for (int idx = gw; idx < T * 2; idx += ngw) {
      const int t = idx >> 1, c = (idx & 1) * 256 + lane * 4;
      const size_t o = (size_t)t * 512 + c;
      const f32x4 ya = *(const f32x4*)(Y0 + o), yb = *(const f32x4*)(Y1 + o);
      const u32x2 rr = *(const u32x2*)(RS + o), kr = *(const u32x2*)(KS + o), vr = *(const u32x2*)(VS + o);
      const u32x2 a0r = *(const u32x2*)(A0 + o), a1r = *(const u32x2*)(A1 + o), gr = *(const u32x2*)(GG + o);
      const f32x4 gw4 = *(const f32x4*)(p.gn_w + c), gb4 = *(const f32x4*)(p.gn_b + c), ka4 = *(const f32x4*)(p.k_a + c), rk4 = *(const f32x4*)(p.r_k + c);
      const f32x4 y = ya + yb;
      const float mean = row_sum16(y[0] + y[1] + y[2] + y[3]) * (1.f / 64.f);
      const f32x4 dl = y - mean;
      const float var = row_sum16(dl[0] * dl[0] + dl[1] * dl[1] + dl[2] * dl[2] + dl[3] * dl[3]) * (1.f / 64.f);
      const float rs = rsqrtf(var + 64e-5f);
      f32x4 r, k, v, a0, a1, g;
      r[0] = bflo(rr.x); r[1] = bfhi(rr.x); r[2] = bflo(rr.y); r[3] = bfhi(rr.y);
      k[0] = bflo(kr.x); k[1] = bfhi(kr.x); k[2] = bflo(kr.y); k[3] = bfhi(kr.y);
      v[0] = bflo(vr.x); v[1] = bfhi(vr.x); v[2] = bflo(vr.y); v[3] = bfhi(vr.y);
      a0[0] = bflo(a0r.x); a0[1] = bfhi(a0r.x); a0[2] = bflo(a0r.y); a0[3] = bfhi(a0r.y);
      a1[0] = bflo(a1r.x); a1[1] = bfhi(a1r.x); a1[2] = bflo(a1r.y); a1[3] = bfhi(a1r.y);
      g[0] = bflo(gr.x); g[1] = bfhi(gr.x); g[2] = bflo(gr.y); g[3] = bfhi(gr.y);
      float bp = 0.f;
#pragma unroll
      for (int j = 0; j < 4; ++j) bp += r[j] * (k[j] * (2.f + (a0[j] + a1[j] - 2.f) * ka4[j])) * rk4[j];
      const float bs = row_sum16(bp);
      f32x4 out;
#pragma unroll
      for (int j = 0; j < 4; ++j) out[j] = (dl[j] * rs * gw4[j] + gb4[j] + bs * v[j]) * g[j];
      st_bf4(YC + (size_t)t * 1024 + 512 + c, out);
    }
  }
  gsync(gbar, bid, nb, 5u);

  {
    EpiB16 e{(bf16_t*)(ws + O_MIX), D};
    gemm_phase<false>((const bf16_t*)(ws + O_YCAT), D, (const bf16_t*)(ws + O_WOUTT), D, D, 4, 0, 4, lds, e, bid, nb, tid);
  }
  gsync(gbar, bid, nb, 6u);

  {
    const bf16_t* mix = (const bf16_t*)(ws + O_MIX);
    bf16_t* x1b = (bf16_t*)(ws + O_X1B);
    for (int row = gw; row < T; row += ngw) {
      const u32x2* mr = (const u32x2*)(mix + (size_t)row * D) + lane;
      const f32x4* xr = (const f32x4*)(p.x + (size_t)row * D) + lane;
      const f32x4* gr = (const f32x4*)(p.post_mix) + lane;
      f32x4 mv[4];
      float s = 0.f;
#pragma unroll
      for (int j = 0; j < 4; ++j) {
        { const u32x2 q_ = mr[64 * j]; mv[j][0] = bflo(q_.x); mv[j][1] = bfhi(q_.x); mv[j][2] = bflo(q_.y); mv[j][3] = bfhi(q_.y); }
        s += mv[j][0] * mv[j][0] + mv[j][1] * mv[j][1] + mv[j][2] * mv[j][2] + mv[j][3] * mv[j][3];
      }
      const float rs = rsqrtf(wave_sum(s) * (1.f / D) + 1e-6f);
      float s2 = 0.f;
      f32x4* orow = (f32x4*)(p.out + (size_t)row * D) + lane;
#pragma unroll
      for (int j = 0; j < 4; ++j) {
        mv[j] = xr[64 * j] + mv[j] * rs * gr[64 * j];
        s2 += mv[j][0] * mv[j][0] + mv[j][1] * mv[j][1] + mv[j][2] * mv[j][2] + mv[j][3] * mv[j][3];
        orow[64 * j] = mv[j];
        st_bf4(x1b + (size_t)row * D + lane * 4 + 256 * j, mv[j]);
      }
      s2 = wave_sum(s2);
      if (lane == 0) rstd2[row] = rsqrtf(s2 * (1.f / D) + 1e-6f);
    }
  }
  gsync(gbar, bid, nb, 7u);

  {
    EpiGate e{rstd2, (bf16_t*)(ws + O_G)};
    gemm_phase<false>((const bf16_t*)(ws + O_X1B), D, (const bf16_t*)(ws + O_WUPT), D, D, 11, 0, 11, lds, e, bid, nb, tid);
  }
  gsync(gbar, bid, nb, 8u);

  {
    EpiUp e{rstd2, (const bf16_t*)(ws + O_G), p.conv_w, p.conv_b, (bf16_t*)(ws + O_ACT)};
    gemm_phase<false>((const bf16_t*)(ws + O_X1B), D, (const bf16_t*)(ws + O_WUPT) + (size_t)DFF * D, D, D, 11, 0, 11, lds, e, bid, nb, tid);
  }
  gsync(gbar, bid, nb, 9u);

  {
    EpiB16 e{(bf16_t*)(ws + O_F), D};
    gemm_phase<false>((const bf16_t*)(ws + O_ACT), DFF, (const bf16_t*)(ws + O_WDOWNT), DFF, DFF, 4, 0, 4, lds, e, bid, nb, tid);
  }
  gsync(gbar, bid, nb, 10u);

  {
    const bf16_t* f = (const bf16_t*)(ws + O_F);
    for (int row = gw; row < T; row += ngw) {
      const u32x2* fr_ = (const u32x2*)(f + (size_t)row * D) + lane;
      const f32x4* gr = (const f32x4*)(p.post_ffn) + lane;
      f32x4* orow = (f32x4*)(p.out + (size_t)row * D) + lane;
      f32x4 fv[4];
      float s = 0.f;
#pragma unroll
      for (int j = 0; j < 4; ++j) {
        { const u32x2 q_ = fr_[64 * j]; fv[j][0] = bflo(q_.x); fv[j][1] = bfhi(q_.x); fv[j][2] = bflo(q_.y); fv[j][3] = bfhi(q_.y); }
        s += fv[j][0] * fv[j][0] + fv[j][1] * fv[j][1] + fv[j][2] * fv[j][2] + fv[j][3] * fv[j][3];
      }
      const float rs = rsqrtf(wave_sum(s) * (1.f / D) + 1e-6f);
#pragma unroll
      for (int j = 0; j < 4; ++j) orow[64 * j] = orow[64 * j] + fv[j] * rs * gr[64 * j];
    }
  }
}

extern "C" void kernel_launch(void* const* d_in, const int* in_sizes, int n_in, void* d_out, int out_size, void* d_ws, size_t ws_size,
                              hipStream_t stream) {
  static int grid_blocks = 0;
  if (grid_blocks == 0) {
    if (n_in != 27 || in_sizes[0] != T * D || out_size != T * D || ws_size < WS_END) {
      fprintf(stderr, "kernel_launch: unexpected shapes (n_in %d, in0 %d, out %d, ws %zu)\n", n_in, n_in > 0 ? in_sizes[0] : -1, out_size, ws_size);
      grid_blocks = -1;
      return;
    }
    int dev = 0, cus = 0, per_cu = 0;
    (void)hipGetDevice(&dev);
    (void)hipDeviceGetAttribute(&cus, hipDeviceAttributeMultiprocessorCount, dev);
    (void)hipFuncSetAttribute((const void*)mega, hipFuncAttributeMaxDynamicSharedMemorySize, LDS_BYTES);
    (void)hipOccupancyMaxActiveBlocksPerMultiprocessor(&per_cu, (const void*)mega, 512, LDS_BYTES);
    if (per_cu < 1) per_cu = 1;
    grid_blocks = cus * per_cu;
  }
  if (grid_blocks < 0) return;
  Params p{};
  const float** pp = (const float**)&p;
  for (int i = 0; i < 27; ++i) pp[i] = (const float*)d_in[i];
  p.out = (float*)d_out;
  p.ws = (unsigned char*)d_ws;
  (void)hipMemsetAsync((char*)d_ws + O_MISC + 4096, 0, 4096, stream);
  void* args[] = {&p};
  hipError_t e = hipLaunchCooperativeKernel((const void*)mega, dim3(grid_blocks), dim3(512), args, LDS_BYTES, stream);
  if (e != hipSuccess) fprintf(stderr, "cooperative launch failed: %s (grid %d)\n", hipGetErrorString(e), grid_blocks);
}
```
